# Optimizing an MI355X kernel written in HIP

```python
import jax, jax.numpy as jnp
from jax import lax
import numpy as np

D_MODEL = 1024
BATCH = 2
SEQ = 8192
DEPTH = 2

D_MIX = D_MODEL
GROUP_WIDTH = D_MIX // 4
POOL_WINDOWS = (2, 4, 8, 16)
POOL_GROUP = GROUP_WIDTH // len(POOL_WINDOWS)
SCONV_K = 3
SSD_D_INNER = GROUP_WIDTH
SSD_HEAD_DIM = 64
SSD_HEADS = SSD_D_INNER // SSD_HEAD_DIM
SSD_GROUPS = 2
SSD_STATE = 128
SSD_CONV_K = 4
SSD_CHUNK = 128
SSD_CONV_DIM = SSD_D_INNER + 2 * SSD_GROUPS * SSD_STATE
S5_WIDTH = GROUP_WIDTH
S5_GROUP = 16
S5_GROUPS = S5_WIDTH // S5_GROUP
S5_STATE = 64
MLP_HIDDEN = 4 * D_MODEL
EPS = 1e-6

IN_SPLITS = (GROUP_WIDTH,
             GROUP_WIDTH, GROUP_WIDTH, GROUP_WIDTH,
             SSD_D_INNER, SSD_CONV_DIM, SSD_HEADS,
             S5_WIDTH)
D_IN_PROJ = sum(IN_SPLITS)
IN_SPLIT_IDX = tuple(int(v) for v in np.cumsum(IN_SPLITS)[:-1])

kernel_name = "hymba_style_pool_conv_ssd_s5_hybrid"

f32 = jnp.float32


def rmsnorm(x, w):
    xf = x.astype(f32)
    y = xf * lax.rsqrt(jnp.mean(xf * xf, axis=-1, keepdims=True) + EPS)
    return (y * w.astype(f32)).astype(x.dtype)


def causal_dwconv(x, w):
    k, ch = w.shape
    return lax.conv_general_dilated(
        x, w[:, None, :].astype(x.dtype), window_strides=(1,),
        padding=[(k - 1, 0)], dimension_numbers=("NWC", "WIO", "NWC"),
        feature_group_count=ch)


def pool_mixer(v, w_grp, scale):
    b, s, _ = v.shape
    vf = v.astype(f32)
    cs = jnp.pad(jnp.cumsum(vf, axis=1), ((0, 0), (1, 0), (0, 0)))
    t = jnp.arange(s)
    outs = []
    for g, win in enumerate(POOL_WINDOWS):
        csg = cs[..., g * POOL_GROUP:(g + 1) * POOL_GROUP]
        start = jnp.maximum(t + 1 - win, 0)
        wsum = csg[:, 1:] - csg[:, start]
        count = jnp.minimum(t + 1, win).astype(f32)[None, :, None]
        outs.append(wsum / count - vf[..., g * POOL_GROUP:(g + 1) * POOL_GROUP])
    p = jnp.stack(outs, axis=2)
    y = jnp.einsum('bsgc,gcd->bsgd', p, w_grp.astype(f32)).reshape(b, s, GROUP_WIDTH)
    return y * scale.astype(f32)


def short_conv_mixer(gate_b, gate_c, h, w):
    return gate_b * causal_dwconv(gate_c * h, w)


def ssd_mixer(z, xbc, dt_raw, conv_w, conv_b, dt_bias, a_log, d_skip):
    b, s, _ = z.shape
    nc = s // SSD_CHUNK
    rep = SSD_HEADS // SSD_GROUPS
    xbc = jax.nn.silu((causal_dwconv(xbc, conv_w) + conv_b).astype(f32))
    xs, bm, cm = jnp.split(xbc, [SSD_D_INNER, SSD_D_INNER + SSD_GROUPS * SSD_STATE], axis=-1)
    xs = xs.reshape(b, nc, SSD_CHUNK, SSD_HEADS, SSD_HEAD_DIM)
    bm = jnp.repeat(bm.reshape(b, nc, SSD_CHUNK, SSD_GROUPS, SSD_STATE), rep, axis=3)
    cm = jnp.repeat(cm.reshape(b, nc, SSD_CHUNK, SSD_GROUPS, SSD_STATE), rep, axis=3)
    dt = jax.nn.softplus(dt_raw.astype(f32) + dt_bias.astype(f32))
    dt = dt.reshape(b, nc, SSD_CHUNK, SSD_HEADS)
    a = -jnp.exp(a_log.astype(f32))
    a_dt = (dt * a).transpose(0, 3, 1, 2)
    x_dt = xs * dt[..., None]
    a_cs = jnp.cumsum(a_dt, axis=-1)
    diff = a_cs[..., :, None] - a_cs[..., None, :]
    causal = jnp.tril(jnp.ones((SSD_CHUNK, SSD_CHUNK), dtype=bool))
    decay = jnp.exp(jnp.where(causal, diff, -jnp.inf))
    scores = jnp.einsum('bclhn,bcshn->bhcls', cm, bm) * decay
    y_diag = jnp.einsum('bhcls,bcshp->bclhp', scores, x_dt)
    decay_to_end = jnp.exp(a_cs[..., -1:] - a_cs)
    states = jnp.einsum('bclhn,bhcl,bclhp->bchpn', bm, decay_to_end, x_dt)
    chunk_decay = jnp.exp(a_cs[..., -1])

    def step(carry, inp):
        st, dec = inp
        return carry * dec[..., None, None] + st, carry

    init = jnp.zeros((b, SSD_HEADS, SSD_HEAD_DIM, SSD_STATE), f32)
    _, prev = lax.scan(step, init, (states.transpose(1, 0, 2, 3, 4), chunk_decay.transpose(2, 0, 1)))
    prev = prev.transpose(1, 0, 2, 3, 4)
    y_off = jnp.einsum('bclhn,bchpn,bhcl->bclhp', cm, prev, jnp.exp(a_cs))
    y = y_diag + y_off + xs * d_skip.astype(f32)[:, None]
    y = y.reshape(b, s, SSD_D_INNER)
    return y * jax.nn.silu(z.astype(f32))


def _complex_affine_combine(e1, e2):
    a1r, a1i, b1r, b1i = e1
    a2r, a2i, b2r, b2i = e2
    return (a2r * a1r - a2i * a1i,
            a2r * a1i + a2i * a1r,
            a2r * b1r - a2i * b1i + b2r,
            a2r * b1i + a2i * b1r + b2i)


def s5_mixer(u, a_re, a_im, log_step, b_re, b_im, c_re, c_im, d_skip, glu_w, glu_b):
    bsz, s, _ = u.shape
    uf = u.astype(f32)
    ug = uf.reshape(bsz, s, S5_GROUPS, S5_GROUP)
    a_re = a_re.astype(f32); a_im = a_im.astype(f32)
    step = jnp.exp(log_step.astype(f32))[:, None]
    mag = jnp.exp(a_re * step)
    lam_re = mag * jnp.cos(a_im * step)
    lam_im = mag * jnp.sin(a_im * step)
    den = a_re * a_re + a_im * a_im
    nr = lam_re - 1.0
    f_re = (nr * a_re + lam_im * a_im) / den
    f_im = (lam_im * a_re - nr * a_im) / den
    b_re = b_re.astype(f32); b_im = b_im.astype(f32)
    bb_re = f_re[..., None] * b_re - f_im[..., None] * b_im
    bb_im = f_re[..., None] * b_im + f_im[..., None] * b_re
    bu_re = jnp.einsum('bsgh,gph->bsgp', ug, bb_re)
    bu_im = jnp.einsum('bsgh,gph->bsgp', ug, bb_im)
    lr = jnp.broadcast_to(lam_re, bu_re.shape)
    li = jnp.broadcast_to(lam_im, bu_re.shape)
    _, _, st_re, st_im = lax.associative_scan(_complex_affine_combine, (lr, li, bu_re, bu_im), axis=1)
    y = (jnp.einsum('bsgp,ghp->bsgh', st_re, c_re.astype(f32))
         - jnp.einsum('bsgp,ghp->bsgh', st_im, c_im.astype(f32)))
    y = y.reshape(bsz, s, S5_WIDTH) + d_skip.astype(f32) * uf
    g = jax.nn.gelu(y)
    return g * jax.nn.sigmoid(g @ glu_w.astype(f32) + glu_b.astype(f32))


def setup_inputs(seed: int = 0) -> dict:
    key = jax.random.key(seed)
    ks = jax.random.split(key, 32)
    L, D = DEPTH, D_MODEL
    nrm = lambda k, shape, sc: jax.random.normal(k, shape, f32) * sc
    gain = lambda k, shape: 1.0 + 0.01 * jax.random.normal(k, shape, f32)
    ssd_dt = jnp.exp(jax.random.uniform(ks[10], (L, SSD_HEADS), f32, np.log(1e-3), np.log(1e-1)))
    s5_a_im = (jnp.pi * jnp.arange(S5_STATE, dtype=f32))[None, None, :] + 0.01 * jax.random.normal(ks[14], (L, S5_GROUPS, S5_STATE), f32)
    return {
        "x": jax.random.normal(ks[0], (BATCH, SEQ, D), f32),
        "c": jax.random.normal(ks[1], (BATCH, D), f32),
        "norm_mix_w": gain(ks[2], (L, D)),
        "norm_mlp_w": gain(ks[3], (L, D)),
        "ada_w": nrm(ks[4], (L, D, 6 * D), 0.5 * D ** -0.5),
        "ada_b": nrm(ks[5], (L, 6 * D), 0.01),
        "w_in": nrm(ks[6], (L, D, D_IN_PROJ), D ** -0.5),
        "pool_w": nrm(ks[7], (L, len(POOL_WINDOWS), POOL_GROUP, POOL_GROUP), POOL_GROUP ** -0.5),
        "pool_scale": 1.0 + 0.1 * jax.random.normal(ks[8], (L, GROUP_WIDTH), f32),
        "sconv_w": nrm(ks[9], (L, SCONV_K, GROUP_WIDTH), SCONV_K ** -0.5),
        "ssd_conv_w": nrm(ks[11], (L, SSD_CONV_K, SSD_CONV_DIM), SSD_CONV_K ** -0.5),
        "ssd_conv_b": nrm(ks[12], (L, SSD_CONV_DIM), 0.01),
        "ssd_dt_bias": ssd_dt + jnp.log(-jnp.expm1(-ssd_dt)),
        "ssd_a_log": jnp.log(jax.random.uniform(ks[13], (L, SSD_HEADS), f32, 1.0, 16.0)),
        "ssd_d": gain(ks[15], (L, SSD_HEADS)),
        "s5_a_re": -0.5 + 0.01 * jax.random.normal(ks[16], (L, S5_GROUPS, S5_STATE), f32),
        "s5_a_im": s5_a_im,
        "s5_log_step": jax.random.uniform(ks[17], (L, S5_GROUPS), f32, np.log(1e-3), np.log(1e-1)),
        "s5_b_re": nrm(ks[18], (L, S5_GROUPS, S5_STATE, S5_GROUP), (2 * S5_GROUP) ** -0.5),
        "s5_b_im": nrm(ks[19], (L, S5_GROUPS, S5_STATE, S5_GROUP), (2 * S5_GROUP) ** -0.5),
        "s5_c_re": nrm(ks[20], (L, S5_GROUPS, S5_GROUP, S5_STATE), S5_STATE ** -0.5),
        "s5_c_im": nrm(ks[21], (L, S5_GROUPS, S5_GROUP, S5_STATE), S5_STATE ** -0.5),
        "s5_d": nrm(ks[22], (L, S5_WIDTH), 1.0),
        "s5_glu_w": nrm(ks[23], (L, S5_WIDTH, S5_WIDTH), S5_WIDTH ** -0.5),
        "s5_glu_b": nrm(ks[24], (L, S5_WIDTH), 0.01),
        "branch_norm_w": gain(ks[25], (L, D_MIX)),
        "w_out": nrm(ks[26], (L, D_MIX, D), D_MIX ** -0.5),
        "mlp_w1": nrm(ks[27], (L, D, MLP_HIDDEN), D ** -0.5),
        "mlp_w2": nrm(ks[28], (L, MLP_HIDDEN, D), MLP_HIDDEN ** -0.5),
        "final_norm_w": gain(ks[29], (D,)),
    }


def reference(x, c, norm_mix_w, norm_mlp_w, ada_w, ada_b, w_in, pool_w, pool_scale,
              sconv_w, ssd_conv_w, ssd_conv_b, ssd_dt_bias, ssd_a_log, ssd_d,
              s5_a_re, s5_a_im, s5_log_step, s5_b_re, s5_b_im, s5_c_re, s5_c_im,
              s5_d, s5_glu_w, s5_glu_b, branch_norm_w, w_out, mlp_w1, mlp_w2,
              final_norm_w):
    dtype = x.dtype
    b, s, _ = x.shape
    cond = jax.nn.silu(c)
    h = x
    for l in range(DEPTH):
        mod = (cond @ ada_w[l] + ada_b[l])[:, None, :]
        sh1, sc1, g1, sh2, sc2, g2 = jnp.split(mod, 6, axis=-1)
        u = rmsnorm(h, norm_mix_w[l]) * (1.0 + sc1) + sh1
        proj = u @ w_in[l]
        (p_pool, p_gb, p_gc, p_h, p_z, p_xbc, p_dt, p_s5) = jnp.split(proj, IN_SPLIT_IDX, axis=-1)
        y_a = pool_mixer(p_pool, pool_w[l], pool_scale[l])
        y_b = short_conv_mixer(p_gb, p_gc, p_h, sconv_w[l])
        y_c = ssd_mixer(p_z, p_xbc, p_dt, ssd_conv_w[l], ssd_conv_b[l],
                        ssd_dt_bias[l], ssd_a_log[l], ssd_d[l])
        y_d = s5_mixer(p_s5, s5_a_re[l], s5_a_im[l], s5_log_step[l], s5_b_re[l],
                       s5_b_im[l], s5_c_re[l], s5_c_im[l], s5_d[l], s5_glu_w[l], s5_glu_b[l])
        groups = jnp.stack([y_a.astype(dtype), y_b.astype(dtype),
                            y_c.astype(dtype), y_d.astype(dtype)], axis=2)
        groups = rmsnorm(groups, branch_norm_w[l].reshape(4, GROUP_WIDTH)).reshape(b, s, D_MIX)
        h = h + g1 * (groups @ w_out[l])
        v = rmsnorm(h, norm_mlp_w[l]) * (1.0 + sc2) + sh2
        h = h + g2 * (jnp.square(jax.nn.relu(v @ mlp_w1[l])) @ mlp_w2[l])
    return rmsnorm(h, final_norm_w)
```

```cpp
#include <hip/hip_runtime.h>
#include <cstdio>
#include <cstdint>
#include <cmath>
namespace pg8 {
#define PG8_LAS __attribute__((address_space(3)))
typedef unsigned short bf16_t;
typedef short bf16x8 __attribute__((ext_vector_type(8)));
typedef float f32x4 __attribute__((ext_vector_type(4)));
typedef unsigned u32x4 __attribute__((ext_vector_type(4)));
constexpr int BM = 256, BK = 64, HALF = 128, HTB = HALF * BK * 2  , STAGE_BYTES = 8 * HTB, NXCD = 8, WGM = 8;

__host__ __device__ __forceinline__ int lds_byte(int r, int c) { const int st = (r >> 4) * 2 + (c >> 5), rr = r & 15, cc = c & 31, ob = rr * 64 + cc * 2; return st * 1024 + (ob ^ (((ob >> 9) & 1) << 5)); }
__host__ __device__ __forceinline__ void stage_rc(int b, int& R, int& C) { const int st = b / 1024, sb = b % 1024, swz = sb ^ (((sb >> 9) & 1) << 5); R = (st >> 1) * 16 + swz / 64; C = (st & 1) * 32 + (swz % 64) / 2; }
__host__ __device__ __forceinline__ int perm32(int rho) { const int n = rho >> 4, i = rho & 15; return 8 * (i >> 2) + 4 * n + (i & 3); }

struct Unit { int pm, pn; };
struct Gemm { const bf16_t* A; const bf16_t* Bt; int M, N, K; };

struct StaticOrder {
    int nM, nN, nwg, G, c;
    __host__ __device__ void init(int M, int N, int G_, int c_) { nM = M / BM; nN = N / BM; nwg = nM * nN; G = G_; c = c_; }
    __host__ __device__ bool next(int i, Unit& u) const {
        const long L = (long)i * G + c; if (L >= nwg) return false;
        int wgid = (int)L; { const int q = nwg / NXCD, r = nwg % NXCD, xcd = wgid % NXCD, off = wgid / NXCD; wgid = (xcd < r ? xcd * (q + 1) : r * (q + 1) + (xcd - r) * q) + off; }
        const int nig = WGM * nN, gid = wgid / nig, fm = gid * WGM, gsz = (nM - fm) < WGM ? (nM - fm) : WGM;
        u.pm = fm + ((wgid % nig) % gsz); u.pn = (wgid % nig) / gsz; return true;
    }
    __device__ __forceinline__ void a_ready(const Unit&) const {}
    __device__ __forceinline__ void done(const Unit&) const {}
};


__device__ __forceinline__ unsigned cvt_pk_bf16(float lo, float hi) { unsigned r; asm volatile("v_cvt_pk_bf16_f32 %0, %1, %2" : "=v"(r) : "v"(lo), "v"(hi)); return r; }

template <int ACT> struct EpiBf16 {
    static constexpr bool PERM = true, AFTER_DRAIN = false;
    bf16_t* O; int ldc;
    __device__ __forceinline__ void operator()(const f32x4 (&acc)[2][2][4][2], const Unit& u, int wr, int wc, int fr, int fq) const {
        const int row0 = u.pm * BM + wr * 64 + fr; const int col0 = u.pn * BM + wc * 32 + 8 * fq;
#pragma unroll
        for (int ai = 0; ai < 2; ++ai)
#pragma unroll
            for (int m = 0; m < 4; ++m) { bf16_t* rowp = O + (size_t)(row0 + ai * HALF + m * 16) * ldc + col0;
#pragma unroll
                for (int bj = 0; bj < 2; ++bj) { f32x4 v0 = acc[ai][bj][m][0], v1 = acc[ai][bj][m][1];
                    if (ACT == 2) {
#pragma unroll
                        for (int e = 0; e < 4; ++e) { const float a = v0[e] > 0.f ? v0[e] : 0.f, b = v1[e] > 0.f ? v1[e] : 0.f; v0[e] = a * a; v1[e] = b * b; } }
                    u32x4 w; w.x = cvt_pk_bf16(v0[0], v0[1]); w.y = cvt_pk_bf16(v0[2], v0[3]); w.z = cvt_pk_bf16(v1[0], v1[1]); w.w = cvt_pk_bf16(v1[2], v1[3]);
                    *(u32x4*)(rowp + bj * HALF) = w; } }
    }
};

struct EpiResGate {
    static constexpr bool PERM = false, AFTER_DRAIN = false;
    const float* base; float* out; int ldc; const float* gp; const float* gb; int gps, gbs, rows_per_batch;
    __device__ __forceinline__ void operator()(const f32x4 (&acc)[2][2][4][2], const Unit& u, int wr, int wc, int fr, int fq) const {
        const int col0 = u.pn * BM + wc * 32 + 4 * fq; const int b = (u.pm * BM) / rows_per_batch;
        f32x4 gv[2][2];
#pragma unroll
        for (int bj = 0; bj < 2; ++bj)
#pragma unroll
            for (int n = 0; n < 2; ++n) { const int c = col0 + bj * HALF + n * 16; const float* q = gp + (size_t)b * gbs + c;
                gv[bj][n] = *(const f32x4*)(gb + c) + ((*(const f32x4*)(q) + *(const f32x4*)(q + gps)) + (*(const f32x4*)(q + 2 * (size_t)gps) + *(const f32x4*)(q + 3 * (size_t)gps))); }
#pragma unroll
        for (int ai = 0; ai < 2; ++ai)
#pragma unroll
            for (int m = 0; m < 4; ++m) { const size_t off = (size_t)(u.pm * BM + ai * HALF + wr * 64 + m * 16 + fr) * ldc + col0;
#pragma unroll
                for (int bj = 0; bj < 2; ++bj)
#pragma unroll
                    for (int n = 0; n < 2; ++n) { const f32x4 bs = *(const f32x4*)(base + off + bj * HALF + n * 16);
                        *(f32x4*)(out + off + bj * HALF + n * 16) = bs + gv[bj][n] * acc[ai][bj][m][n]; }
                if (m & 1) asm volatile("" ::: "memory"); }
    }
};

template <class Epi, class Sched, bool ALIGN_EPI = false, bool SP2 = false>
__device__ __forceinline__ void gemm_phase(PG8_LAS unsigned char* lds, const Gemm g, const Sched& S, const Epi& E) {
    const int tid = threadIdx.x, wid = __builtin_amdgcn_readfirstlane(tid >> 6), lane = tid & 63, wr = wid >> 2, wc = wid & 3, fr = lane & 15, fq = lane >> 4;
    const int K = g.K, nt = K / BK;
    unsigned voffA[2], voffB[2];
#pragma unroll
    for (int i = 0; i < 2; ++i) { int R, C; stage_rc(tid * 16 + i * 8192, R, C); const int Rb = Epi::PERM ? ((R & ~31) + perm32(R & 31)) : R;
        voffA[i] = (unsigned)(R * K + C) * 2u; voffB[i] = (unsigned)(Rb * K + C) * 2u; }
    const size_t kstep = (size_t)(BK * 2);
    const size_t hstep = (size_t)HALF * K * 2;
    const size_t tstep = 2 * hstep;
    const unsigned ldsw = (unsigned)wid * 1024u;
    const int aoff = lds_byte(wr * 64 + fr, fq * 8), boff = lds_byte(wc * 32 + fr, fq * 8);
#define PG8_SA(b, h) (((b) * 2 + (h)) * HTB)
#define PG8_SB(b, h) ((4 + (b) * 2 + (h)) * HTB)
#define PG8_STAGE(bufoff, gbase, voff) do { _Pragma("unroll") for (int _i = 0; _i < 2; ++_i) \
        __builtin_amdgcn_global_load_lds((const unsigned*)((const char*)(gbase) + (voff)[_i]), (PG8_LAS unsigned*)(lds + (bufoff) + ldsw + _i * 8192), 16, 0, 0); } while (0)
#define PG8_LDA(dst, b, h) do { _Pragma("unroll") for (int m = 0; m < 4; ++m) _Pragma("unroll") for (int k = 0; k < 2; ++k) dst[m][k] = *(const PG8_LAS bf16x8*)(lds + PG8_SA(b, h) + aoff + m * 2048 + k * 1024); } while (0)
#define PG8_LDB(dst, b, h) do { _Pragma("unroll") for (int n = 0; n < 2; ++n) _Pragma("unroll") for (int k = 0; k < 2; ++k) dst[n][k] = *(const PG8_LAS bf16x8*)(lds + PG8_SB(b, h) + boff + n * 2048 + k * 1024); } while (0)
#define PG8_MMA(ai, bj, At, Bt) do { __builtin_amdgcn_s_setprio(1); _Pragma("unroll") for (int m = 0; m < 4; ++m) _Pragma("unroll") for (int n = 0; n < 2; ++n) _Pragma("unroll") for (int k = 0; k < 2; ++k) \
        acc[ai][bj][m][n] = __builtin_amdgcn_mfma_f32_16x16x32_bf16(Bt[n][k], At[m][k], acc[ai][bj][m][n], 0, 0, 0); __builtin_amdgcn_s_setprio(0); } while (0)
#define PG8_WAIT_V(n) asm volatile("s_waitcnt vmcnt(" #n ")" ::: "memory")
#define PG8_WAIT_L(n) asm volatile("s_waitcnt lgkmcnt(" #n ")" ::: "memory")
#define PG8_BAR __builtin_amdgcn_s_barrier()
#define PG8_SCHED __builtin_amdgcn_sched_barrier(0)
    Unit cur, nxt; int ui = 0;
    if (!S.next(0, cur)) return;
    f32x4 acc[2][2][4][2];
#pragma unroll
    for (int a = 0; a < 2; ++a)
#pragma unroll
        for (int b = 0; b < 2; ++b)
#pragma unroll
            for (int m = 0; m < 4; ++m)
#pragma unroll
                for (int n = 0; n < 2; ++n) acc[a][b][m][n] = (f32x4){0.f, 0.f, 0.f, 0.f};
    bf16x8 At[4][2], B0[2][2], B1[2][2];
    const char* cA = (const char*)g.A + (size_t)cur.pm * tstep; const char* cB = (const char*)g.Bt + (size_t)cur.pn * tstep;
    S.a_ready(cur);
    if constexpr (SP2) {
        PG8_STAGE(PG8_SB(0, 0), cB, voffB); PG8_STAGE(PG8_SB(0, 1), cB + hstep, voffB); PG8_STAGE(PG8_SA(0, 0), cA, voffA); PG8_STAGE(PG8_SA(0, 1), cA + hstep, voffA);
        if (wr == 1) PG8_BAR;
        PG8_WAIT_V(2); PG8_BAR;
        PG8_STAGE(PG8_SB(1, 0), cB + kstep, voffB); PG8_STAGE(PG8_SA(1, 0), cA + kstep, voffA); PG8_STAGE(PG8_SB(1, 1), cB + hstep + kstep, voffB);
        PG8_WAIT_V(6); PG8_BAR;
    } else {
        PG8_STAGE(PG8_SB(0, 0), cB, voffB); PG8_STAGE(PG8_SA(0, 0), cA, voffA); PG8_STAGE(PG8_SB(0, 1), cB + hstep, voffB); PG8_STAGE(PG8_SA(0, 1), cA + hstep, voffA);
        if (wr == 1) PG8_BAR;
        PG8_WAIT_V(4); PG8_BAR;
        PG8_STAGE(PG8_SB(1, 0), cB + kstep, voffB); PG8_STAGE(PG8_SA(1, 0), cA + kstep, voffA); PG8_STAGE(PG8_SB(1, 1), cB + hstep + kstep, voffB);
        PG8_WAIT_V(6); PG8_BAR;
    }
    for (;;) {
        const bool has_next = S.next(ui + 1, nxt);
        const char* nA = has_next ? (const char*)g.A + (size_t)nxt.pm * tstep : cA; const char* nB = has_next ? (const char*)g.Bt + (size_t)nxt.pn * tstep : cB;
        for (int t = 0; t < nt; t += 2) {
            const bool last = (t == nt - 2);
            const char* a1 = cA + (size_t)(t + 1) * kstep;
            const char* a2 = last ? nA : cA + (size_t)(t + 2) * kstep; const char* b2 = last ? nB : cB + (size_t)(t + 2) * kstep;
            const char* a3 = a2 + kstep; const char* b3 = b2 + kstep;
            if (last && has_next) S.a_ready(nxt);
            if constexpr (SP2) {
            PG8_LDB(B0, 0, 0); PG8_LDB(B1, 0, 1); PG8_SCHED; PG8_LDA(At, 0, 0); PG8_STAGE(PG8_SA(1, 1), a1 + hstep, voffA);
            PG8_WAIT_V(8); PG8_WAIT_L(0); PG8_BAR; PG8_MMA(0, 0, At, B0); PG8_MMA(0, 1, At, B1); PG8_BAR; PG8_SCHED;
            PG8_LDA(At, 0, 1); PG8_STAGE(PG8_SB(0, 0), b2, voffB); PG8_STAGE(PG8_SB(0, 1), b2 + hstep, voffB); PG8_STAGE(PG8_SA(0, 0), a2, voffA);
            PG8_WAIT_V(8); PG8_WAIT_L(0); PG8_BAR; PG8_MMA(1, 0, At, B0); PG8_MMA(1, 1, At, B1); PG8_BAR; PG8_SCHED;
            PG8_LDB(B0, 1, 0); PG8_LDB(B1, 1, 1); PG8_SCHED; PG8_LDA(At, 1, 0); PG8_STAGE(PG8_SA(0, 1), a2 + hstep, voffA);
            PG8_WAIT_V(8); PG8_WAIT_L(0); PG8_BAR; PG8_MMA(0, 0, At, B0); PG8_MMA(0, 1, At, B1); PG8_BAR; PG8_SCHED;
            PG8_LDA(At, 1, 1); PG8_STAGE(PG8_SB(1, 0), b3, voffB); PG8_STAGE(PG8_SB(1, 1), b3 + hstep, voffB); PG8_STAGE(PG8_SA(1, 0), a3, voffA);
            PG8_WAIT_V(8); PG8_WAIT_L(0); PG8_BAR; PG8_MMA(1, 0, At, B0); PG8_MMA(1, 1, At, B1); PG8_BAR; PG8_SCHED;
            } else {
            PG8_LDB(B0, 0, 0); PG8_SCHED; PG8_LDA(At, 0, 0); PG8_STAGE(PG8_SA(1, 1), a1 + hstep, voffA);
            PG8_WAIT_L(8); PG8_BAR; PG8_WAIT_L(0); PG8_MMA(0, 0, At, B0); PG8_BAR; PG8_SCHED;
            PG8_LDB(B1, 0, 1); PG8_STAGE(PG8_SB(0, 0), b2, voffB);
            PG8_BAR; PG8_WAIT_L(0); PG8_MMA(0, 1, At, B1); PG8_BAR;
            PG8_LDA(At, 0, 1); PG8_STAGE(PG8_SA(0, 0), a2, voffA);
            PG8_BAR; PG8_WAIT_L(0); PG8_MMA(1, 0, At, B0); PG8_BAR; PG8_SCHED;
            PG8_STAGE(PG8_SB(0, 1), b2 + hstep, voffB);
            PG8_WAIT_V(6); PG8_BAR; PG8_MMA(1, 1, At, B1); PG8_BAR;
            PG8_LDB(B0, 1, 0); PG8_SCHED; PG8_LDA(At, 1, 0); PG8_STAGE(PG8_SA(0, 1), a2 + hstep, voffA);
            PG8_WAIT_L(8); PG8_BAR; PG8_WAIT_L(0); PG8_MMA(0, 0, At, B0); PG8_BAR; PG8_SCHED;
            PG8_LDB(B1, 1, 1); PG8_STAGE(PG8_SB(1, 0), b3, voffB);
            PG8_BAR; PG8_WAIT_L(0); PG8_MMA(0, 1, At, B1); PG8_BAR;
            PG8_LDA(At, 1, 1); PG8_STAGE(PG8_SA(1, 0), a3, voffA);
            PG8_BAR; PG8_WAIT_L(0); PG8_MMA(1, 0, At, B0); PG8_BAR; PG8_SCHED;
            PG8_STAGE(PG8_SB(1, 1), b3 + hstep, voffB);
            PG8_WAIT_V(6); PG8_BAR; PG8_MMA(1, 1, At, B1); PG8_BAR;
            }
        }
        if constexpr (ALIGN_EPI) { if (wr == 0) PG8_BAR; }
        if constexpr (!Epi::AFTER_DRAIN) { E(acc, cur, wr, wc, fr, fq); S.done(cur); }
        if (!has_next) break;
#pragma unroll
        for (int a = 0; a < 2; ++a)
#pragma unroll
            for (int b = 0; b < 2; ++b)
#pragma unroll
                for (int m = 0; m < 4; ++m)
#pragma unroll
                    for (int n = 0; n < 2; ++n) acc[a][b][m][n] = (f32x4){0.f, 0.f, 0.f, 0.f};
        cur = nxt; cA = nA; cB = nB; ++ui;
        if constexpr (ALIGN_EPI) { if (wr == 1) PG8_BAR; }
    }
    PG8_WAIT_V(0);
    if constexpr (!ALIGN_EPI) { if (wr == 0) PG8_BAR; }
    PG8_BAR;
    if constexpr (Epi::AFTER_DRAIN) { E.fused(acc, cur, wr, wc, fr, fq, lds, wid, lane); S.done(cur); }
#undef PG8_SA
#undef PG8_SB
#undef PG8_STAGE
#undef PG8_LDA
#undef PG8_LDB
#undef PG8_MMA
#undef PG8_WAIT_V
#undef PG8_WAIT_L
#undef PG8_BAR
#undef PG8_SCHED
}
}

constexpr int NWAVES = 8;
constexpr int BATCH = 2, SEQ = 8192, D = 1024, M = BATCH * SEQ, DEPTH = 2;
constexpr int NPROJ_SRC = 2308, NPROJ = 2304, FF = 4096, MOD = 6 * D;
constexpr float EPS = 1e-6f;
constexpr int PC_POOL = 0, PC_GB = 256, PC_GC = 512, PC_H = 768, PC_Z = 1024, PC_X = 1280, PC_B = 1536, PC_C = 1792, PC_S5 = 2048;
enum { I_X = 0, I_C, I_NMIX, I_NMLP, I_ADAW, I_ADAB, I_WIN, I_POOLW, I_POOLS, I_SCONVW, I_SSDCW, I_SSDCB, I_DTB, I_ALOG, I_SSDD, I_S5ARE, I_S5AIM, I_S5LS, I_S5BRE, I_S5BIM,
       I_S5CRE, I_S5CIM, I_S5D, I_GLUW, I_GLUB, I_BNW, I_WOUT, I_W1, I_W2, I_FNW, N_IN };

constexpr size_t MiB = 1u << 20;
constexpr size_t WS_CTL = 0, CTL_ZERO_BYTES = 1 * MiB;
constexpr size_t WS_WIN = 1 * MiB;
constexpr size_t WS_WOUT = 10 * MiB;
constexpr size_t WS_W1 = 14 * MiB;
constexpr size_t WS_W2 = 30 * MiB;
constexpr size_t WS_UV = 46 * MiB;
constexpr size_t WS_PROJ = 78 * MiB;
constexpr size_t WS_GROUPS = 150 * MiB;
constexpr size_t WS_YC = 182 * MiB;
constexpr size_t WS_YS = 198 * MiB;
constexpr size_t WS_HID = 78 * MiB;
constexpr size_t WS_MODP = 214 * MiB;
constexpr size_t WS_DT = 215 * MiB;
constexpr size_t WS_WDT = 215 * MiB + 512 * 1024;
constexpr size_t WS_END = 216 * MiB;
constexpr int CW_BAR = 4096;

constexpr int RING_OFF = 0, RING_BYTES = 131072;
constexpr int LDSCTL_OFF = RING_BYTES, MISC_OFF = LDSCTL_OFF + 320;
constexpr int LDS_BYTES = 147456;
#define GAS __attribute__((address_space(1)))
#define LAS __attribute__((address_space(3)))
typedef unsigned short bf16;
typedef unsigned v4u __attribute__((ext_vector_type(4)));
typedef float f32x4 __attribute__((ext_vector_type(4)));
typedef short bf16x8 __attribute__((ext_vector_type(8)));
typedef GAS unsigned gu32;
typedef GAS unsigned long long gu64;
#define RLX_AGENT __ATOMIC_RELAXED, __HIP_MEMORY_SCOPE_AGENT
#define LDS_WAIT() asm volatile("s_waitcnt lgkmcnt(0)" ::: "memory")
#define VM_WAIT() asm volatile("s_waitcnt vmcnt(0)" ::: "memory")
__device__ __forceinline__ unsigned long long rt() { return __builtin_amdgcn_s_memrealtime(); }
__device__ __forceinline__ unsigned f2bf(float f) { unsigned u = __builtin_bit_cast(unsigned, f); return (u + 0x7fffu + ((u >> 16) & 1u)) >> 16; }
__device__ __forceinline__ unsigned pk2(float lo, float hi) { return f2bf(lo) | (f2bf(hi) << 16); }

#define XB_TMO      128
#define XB_XCNT(j)  (256  + 64 * (j))
#define XB_XSUB(j)  (1280 + 64 * (j))
#define XB_XGEN(j)  (2304 + 64 * (j))
#define XB_TOP      3328
#define XB_TOPGEN   3392
#define XCD_BAR_WORDS 3456
#define XB_SPIN_CAP (1u << 18)

__device__ __forceinline__ unsigned xb_ld(unsigned* p)              { return __hip_atomic_load(p, __ATOMIC_RELAXED, __HIP_MEMORY_SCOPE_AGENT); }
__device__ __forceinline__ unsigned xb_add(unsigned* p, unsigned v) { return __hip_atomic_fetch_add(p, v, __ATOMIC_RELAXED, __HIP_MEMORY_SCOPE_AGENT); }
__device__ __forceinline__ unsigned xb_xcc_id() { return (unsigned)__builtin_amdgcn_s_getreg((3 << 11) | 20) & 0xFu; }
#define XB_SPIN(cond, bar) do { unsigned _sp = 0; while (cond) { __builtin_amdgcn_s_sleep(1); \
    if ((++_sp & 255u) == 0u) { if (xb_ld(&(bar)[XB_TMO])) break; if (_sp > XB_SPIN_CAP) { atomicAdd(&(bar)[XB_TMO], 1u); break; } } } } while (0)

struct XcdBarrier {
    unsigned* bar; unsigned x;
    volatile LAS unsigned* st;
};

__device__ __forceinline__ XcdBarrier xcd_barrier_post(unsigned* bar, volatile LAS unsigned* st) {
    XcdBarrier b; b.bar = bar; b.x = xb_xcc_id(); b.st = st;
    if (threadIdx.x == 0) (void)xb_add(&bar[XB_XCNT(b.x)], 1u);
    return b;
}
__device__ __forceinline__ void xcd_barrier_complete(unsigned* bar, unsigned x, unsigned& nloc, unsigned& nx) {
    const unsigned G = gridDim.x * gridDim.y * gridDim.z;
    unsigned sum, cnt, mine, sp = 0u;
    for (;;) {
        sum = 0u; cnt = 0u; mine = 0u;
#pragma unroll
        for (unsigned j = 0; j < 16; ++j) { const unsigned c = xb_ld(&bar[XB_XCNT(j)]); sum += c; cnt += (c > 0u) ? 1u : 0u; mine = (j == x) ? c : mine; }
        if (sum == G) break;
        __builtin_amdgcn_s_sleep(1);
        if ((++sp & 255u) == 0u) { if (xb_ld(&bar[XB_TMO])) break; if (sp > XB_SPIN_CAP) { atomicAdd(&bar[XB_TMO], 1u); break; } }
    }
    nloc = mine > 0u ? mine : 1u; nx = cnt > 0u ? cnt : 1u;
}

__device__ __forceinline__ void xcd_barrier(const XcdBarrier& b) {
    asm volatile("s_waitcnt vmcnt(0)" ::: "memory");
    __syncthreads();
    if (threadIdx.x == 0) {
        unsigned* bar = b.bar; asm volatile("" : "+s"(bar));
        __builtin_amdgcn_s_waitcnt(0);
        unsigned nloc = b.st[0], nx = b.st[1];
        if (nloc == 0u) { xcd_barrier_complete(bar, b.x, nloc, nx); b.st[0] = nloc; b.st[1] = nx; }
        const unsigned old = xb_add(&bar[XB_XSUB(b.x)], 1u);
        const unsigned gen = old / nloc;
        if (old + 1u == (gen + 1u) * nloc) {
            __builtin_amdgcn_fence(__ATOMIC_RELEASE, "agent");
            asm volatile("s_waitcnt vmcnt(0)" ::: "memory");
            const unsigned og = xb_add(&bar[XB_TOP], 1u);
            const unsigned tg = og / nx;
            if (og + 1u == (tg + 1u) * nx) xb_add(&bar[XB_TOPGEN], 1u);
            else XB_SPIN(xb_ld(&bar[XB_TOPGEN]) == tg, bar);
            __builtin_amdgcn_fence(__ATOMIC_ACQUIRE, "agent");
            xb_add(&bar[XB_XGEN(b.x)], 1u);
            asm volatile("s_waitcnt vmcnt(0)" ::: "memory");
        } else {
            XB_SPIN(xb_ld(&bar[XB_XGEN(b.x)]) == gen, bar);
            __builtin_amdgcn_fence(__ATOMIC_ACQUIRE, "agent");
            asm volatile("s_waitcnt vmcnt(0)" ::: "memory");
        }
    }
    __syncthreads();
}

struct Frame {
    LAS unsigned char* lds;
    volatile LAS unsigned* MISC;
    gu32* ctl;
    int tid, lane, wave;
    int vcu, G;
    const __attribute__((address_space(4))) unsigned char* karg;
    unsigned char* ws;
};
#define FIN(i) (*(const float* const __attribute__((address_space(4)))*)(F.karg + 8 * (i)))
#define F_H (*(float* const __attribute__((address_space(4)))*)(F.karg + 8 * N_IN))
#define F_WinT ((bf16*)(F.ws + WS_WIN))
#define F_WoutT ((bf16*)(F.ws + WS_WOUT))
#define F_W1T ((bf16*)(F.ws + WS_W1))
#define F_W2T ((bf16*)(F.ws + WS_W2))
#define F_UV ((bf16*)(F.ws + WS_UV))
#define F_PROJ ((bf16*)(F.ws + WS_PROJ))
#define F_GROUPS ((bf16*)(F.ws + WS_GROUPS))
#define F_HID ((bf16*)(F.ws + WS_HID))
#define F_YC ((float*)(F.ws + WS_YC))
#define F_YS ((float*)(F.ws + WS_YS))
#define F_MODP ((float*)(F.ws + WS_MODP))
#define F_DT ((float*)(F.ws + WS_DT))
#define F_WDT ((float*)(F.ws + WS_WDT))

__device__ __forceinline__ float wave_sum(float v) {
#pragma unroll
    for (int o = 1; o < 64; o <<= 1) v += __shfl_xor(v, o);
    return v;
}
__device__ __forceinline__ float bf2f(bf16 h) { return __uint_as_float(((unsigned)h) << 16); }
__device__ __forceinline__ float siluf(float x) { return x / (1.f + __expf(-x)); }
__device__ __forceinline__ float sigmf(float x) { return 1.f / (1.f + __expf(-x)); }
__device__ __forceinline__ float softplusf(float x) { return x > 20.f ? x : log1pf(__expf(x)); }
__device__ __forceinline__ float gelu_tanh(float x) { const float t = tanhf(0.7978845608028654f * (x + 0.044715f * x * x * x)); return 0.5f * x * (1.f + t); }

__device__ __forceinline__ f32x4 modv4(const Frame& F, int l, int b, int idx, int col) {
    const float* q = F_MODP + ((size_t)l * 2 + b) * MOD + idx * D + col; constexpr size_t PS = (size_t)2 * 2 * MOD;
    return *(const f32x4*)(FIN(I_ADAB) + (size_t)l * MOD + idx * D + col) + ((*(const f32x4*)q + *(const f32x4*)(q + PS)) + (*(const f32x4*)(q + 2 * PS) + *(const f32x4*)(q + 3 * PS)));
}

__device__ __forceinline__ void p0_transpose_item(const float* W, int K, int Nsrc, int nblk, int shift_from, int shift, bf16* WT, LAS float* scr, int item, int lane) {
    const int kb = item / nblk, nb = item % nblk, k0 = 64 * kb, n0 = 32 * nb, n0s = n0 + (n0 >= shift_from ? shift : 0);
#pragma unroll 8
    for (int i = 0; i < 32; ++i) { const int kk = 2 * i + (lane >> 5); scr[kk * 33 + (lane & 31)] = W[(size_t)(k0 + kk) * Nsrc + n0s + (lane & 31)]; }
    LDS_WAIT(); asm volatile("" ::: "memory");
    const int c = lane & 7;
#pragma unroll
    for (int j = 0; j < 4; ++j) { const int n = (lane >> 3) + 8 * j; const LAS float* s = scr + (8 * c) * 33 + n;
        v4u o; o.x = pk2(s[0 * 33], s[1 * 33]); o.y = pk2(s[2 * 33], s[3 * 33]); o.z = pk2(s[4 * 33], s[5 * 33]); o.w = pk2(s[6 * 33], s[7 * 33]);
        *(GAS v4u*)(WT + (size_t)(n0 + n) * K + k0 + 8 * c) = o; }
    LDS_WAIT(); asm volatile("" ::: "memory");
}

__device__ __forceinline__ void p0_prologue(Frame& F) {
    if (F.vcu < 192) {
        const int l = F.vcu / 96, rem = F.vcu % 96, cb = rem / 4, kq = rem % 4;
        const float* W = FIN(I_ADAW) + (size_t)l * D * MOD + cb * 256 + 4 * F.lane; const float* c = FIN(I_C);
        f32x4 a0 = {0.f, 0.f, 0.f, 0.f}, a1 = {0.f, 0.f, 0.f, 0.f};
        const int kbeg = kq * 256 + F.wave * 32;
#pragma unroll 8
        for (int k = kbeg; k < kbeg + 32; ++k) { const f32x4 w = *(const f32x4*)(W + (size_t)k * MOD); const float c0 = siluf(c[k]), c1 = siluf(c[D + k]); a0 += w * c0; a1 += w * c1; }
        LAS f32x4* red = (LAS f32x4*)(F.lds);
        red[(F.wave * 64 + F.lane) * 2 + 0] = a0; red[(F.wave * 64 + F.lane) * 2 + 1] = a1;
        __syncthreads();
        if (F.wave == 0) {
            f32x4 s0 = {0.f, 0.f, 0.f, 0.f}, s1 = {0.f, 0.f, 0.f, 0.f};
#pragma unroll
            for (int w = 0; w < 8; ++w) { s0 += red[(w * 64 + F.lane) * 2 + 0]; s1 += red[(w * 64 + F.lane) * 2 + 1]; }
            float* o = F_MODP + ((size_t)(kq * 2 + l) * 2) * MOD + cb * 256 + 4 * F.lane;
            *(f32x4*)o = s0; *(f32x4*)(o + MOD) = s1;
        }
        __syncthreads();
    }
    LAS float* scr = (LAS float*)(F.lds + RING_OFF + F.wave * 16384);
    const int gw = F.vcu * NWAVES + F.wave, NGW = F.G * NWAVES;
    for (int i = gw * 64 + F.lane; i < DEPTH * D; i += NGW * 64) { const int l = i / D, k = i % D;
        *(f32x4*)(F_WDT + (size_t)i * 4) = *(const f32x4*)(FIN(I_WIN) + ((size_t)l * D + k) * NPROJ_SRC + 2048); }
    constexpr int I_IN = (D / 64) * (NPROJ / 32), I_O = (D / 64) * (D / 32), I_1 = (D / 64) * (FF / 32), I_2 = (FF / 64) * (D / 32), I_L = I_IN + I_O + I_1 + I_2;
    for (int it = gw; it < DEPTH * I_L; it += NGW) {
        const int l = it / I_L; int r = it % I_L;
        if (r < I_IN) { p0_transpose_item(FIN(I_WIN) + (size_t)l * D * NPROJ_SRC, D, NPROJ_SRC, NPROJ / 32, 2048, 4, F_WinT + (size_t)l * NPROJ * D, scr, r, F.lane); continue; } r -= I_IN;
        if (r < I_O) { p0_transpose_item(FIN(I_WOUT) + (size_t)l * D * D, D, D, D / 32, 1 << 30, 0, F_WoutT + (size_t)l * D * D, scr, r, F.lane); continue; } r -= I_O;
        if (r < I_1) { p0_transpose_item(FIN(I_W1) + (size_t)l * D * FF, D, FF, FF / 32, 1 << 30, 0, F_W1T + (size_t)l * FF * D, scr, r, F.lane); continue; } r -= I_1;
        p0_transpose_item(FIN(I_W2) + (size_t)l * FF * D, FF, D, D / 32, 1 << 30, 0, F_W2T + (size_t)l * D * FF, scr, r, F.lane);
    }
}

__device__ __forceinline__ void norm_phase(Frame& F, const float* src, const float* nw, int l, int sh_idx, int sc_idx, bf16* dst, bool do_dt) {
    const int gw = F.vcu * NWAVES + F.wave, NGW = F.G * NWAVES, lane = F.lane;
    for (int blk = gw; blk < M / 8; blk += NGW) {
        const int m0 = blk * 8, b = m0 / SEQ;
        f32x4 nwv[4], shv[4], scv[4];
#pragma unroll
        for (int j = 0; j < 4; ++j) { const int col = 4 * lane + 256 * j; nwv[j] = *(const f32x4*)(nw + col); shv[j] = modv4(F, l, b, sh_idx, col); scv[j] = modv4(F, l, b, sc_idx, col) + 1.0f;
            asm volatile("" : "+v"(shv[j]), "+v"(scv[j]) :: "memory"); }
        for (int i = 0; i < 8; ++i) {
            const int m = m0 + i;
            const f32x4* xr = (const f32x4*)(src + (size_t)m * D) + lane;
            f32x4 v[4]; float ss = 0.f;
#pragma unroll
            for (int j = 0; j < 4; ++j) { v[j] = xr[64 * j]; ss += (v[j].x * v[j].x + v[j].y * v[j].y) + (v[j].z * v[j].z + v[j].w * v[j].w); }
            const float r = 1.0f / sqrtf(wave_sum(ss) * (1.0f / D) + EPS);
            unsigned long long* o8 = (unsigned long long*)(dst + (size_t)m * D) + lane;
#pragma unroll
            for (int j = 0; j < 4; ++j) { v[j] = (v[j] * r) * nwv[j] * scv[j] + shv[j];
                o8[64 * j] = (unsigned long long)pk2(v[j].x, v[j].y) | ((unsigned long long)pk2(v[j].z, v[j].w) << 32); }
            if (do_dt) {
                const float* wdt = F_WDT + (size_t)l * D * 4 + 16 * lane;
                f32x4 d = {0.f, 0.f, 0.f, 0.f};
#pragma unroll
                for (int j = 0; j < 4; ++j)
#pragma unroll
                    for (int e = 0; e < 4; ++e) d += *(const f32x4*)(wdt + (256 * j + e) * 4) * v[j][e];
                d.x = wave_sum(d.x); d.y = wave_sum(d.y); d.z = wave_sum(d.z); d.w = wave_sum(d.w);
                if (lane == 0) *(f32x4*)(F_DT + (size_t)m * 4) = d;
            }
        }
    }
}

__device__ __forceinline__ void final_norm_phase(Frame& F) {
    const int gw = F.vcu * NWAVES + F.wave, NGW = F.G * NWAVES, lane = F.lane; const float* nw = FIN(I_FNW);
    f32x4 nwv[4];
#pragma unroll
    for (int j = 0; j < 4; ++j) nwv[j] = *(const f32x4*)(nw + 4 * lane + 256 * j);
    for (int m = gw; m < M; m += NGW) {
        f32x4* xr = (f32x4*)(F_H + (size_t)m * D) + lane;
        f32x4 v[4]; float ss = 0.f;
#pragma unroll
        for (int j = 0; j < 4; ++j) { v[j] = xr[64 * j]; ss += (v[j].x * v[j].x + v[j].y * v[j].y) + (v[j].z * v[j].z + v[j].w * v[j].w); }
        const float r = 1.0f / sqrtf(wave_sum(ss) * (1.0f / D) + EPS);
#pragma unroll
        for (int j = 0; j < 4; ++j) xr[64 * j] = (v[j] * r) * nwv[j];
    }
}

__device__ __forceinline__ void x1_pool_sconv(Frame& F, int l) {
    const int gw = F.vcu * NWAVES + F.wave, NGW = F.G * NWAVES, lane = F.lane;
    LAS float* ps = (LAS float*)(F.lds + RING_OFF + F.wave * 16384);
    const float* pw = FIN(I_POOLW) + (size_t)l * 4 * 64 * 64; const float* pscale = FIN(I_POOLS) + l * 256; const float* bnw = FIN(I_BNW) + l * D;
    const float* sw = FIN(I_SCONVW) + (size_t)l * 3 * 256;
    for (int blk = gw; blk < M / 8; blk += NGW) {
        const int m0 = blk * 8;
        {
            float s[8][4], v0[8][4];
#pragma unroll
            for (int tok = 0; tok < 8; ++tok)
#pragma unroll
                for (int g = 0; g < 4; ++g) { s[tok][g] = 0.f; v0[tok][g] = 0.f; }
            const int t0 = m0 & (SEQ - 1);
#pragma unroll 1
            for (int rr = -15; rr < 8; ++rr) {
                if (t0 + rr < 0) continue;
                const bf16* row = F_PROJ + (size_t)(m0 + rr) * NPROJ + PC_POOL + lane;
                float x[4];
#pragma unroll
                for (int g = 0; g < 4; ++g) x[g] = bf2f(row[g * 64]);
#pragma unroll
                for (int tok = 0; tok < 8; ++tok) { const int j = tok - rr;
#pragma unroll
                    for (int g = 0; g < 4; ++g) { const bool in = (j >= 0) && (j < (2 << g)); s[tok][g] += in ? x[g] : 0.f; v0[tok][g] = (j == 0) ? x[g] : v0[tok][g]; } }
            }
#pragma unroll
            for (int tok = 0; tok < 8; ++tok) { const int t = t0 + tok;
#pragma unroll
                for (int g = 0; g < 4; ++g) { const int win = 2 << g, cnt = (t + 1 < win) ? (t + 1) : win; ps[tok * 256 + g * 64 + lane] = s[tok][g] / (float)cnt - v0[tok][g]; } }
        }
        LDS_WAIT(); asm volatile("" ::: "memory");
        float acc[8][4];
#pragma unroll
        for (int tok = 0; tok < 8; ++tok)
#pragma unroll
            for (int g = 0; g < 4; ++g) acc[tok][g] = 0.f;
        for (int c = 0; c < 64; ++c) {
            float w[4];
#pragma unroll
            for (int g = 0; g < 4; ++g) w[g] = pw[(size_t)(g * 64 + c) * 64 + lane];
#pragma unroll
            for (int tok = 0; tok < 8; ++tok)
#pragma unroll
                for (int g = 0; g < 4; ++g) acc[tok][g] += ps[tok * 256 + g * 64 + c] * w[g];
        }
        LDS_WAIT(); asm volatile("" ::: "memory");
#pragma unroll
        for (int tok = 0; tok < 8; ++tok) {
            const int m = m0 + tok; float y[4], ss = 0.f;
#pragma unroll
            for (int g = 0; g < 4; ++g) { y[g] = acc[tok][g] * pscale[g * 64 + lane]; ss += y[g] * y[g]; }
            const float r = 1.0f / sqrtf(wave_sum(ss) * (1.0f / 256.f) + EPS);
#pragma unroll
            for (int g = 0; g < 4; ++g) F_GROUPS[(size_t)m * D + g * 64 + lane] = (bf16)f2bf(y[g] * r * bnw[g * 64 + lane]);
        }
        for (int tok = 0; tok < 8; ++tok) {
            const int m = m0 + tok, t = m & (SEQ - 1); float y[4], ss = 0.f;
#pragma unroll
            for (int j = 0; j < 4; ++j) {
                const int c = lane + 64 * j; const bf16* row = F_PROJ + (size_t)m * NPROJ;
                float a = 0.f;
#pragma unroll
                for (int k = 0; k < 3; ++k) { const int back = 2 - k; const bool ok = t >= back; const bf16* rr = row - (ok ? (size_t)back * NPROJ : 0);
                    const float gc = bf2f(rr[PC_GC + c]), hh = bf2f(rr[PC_H + c]); a += ok ? sw[k * 256 + c] * (gc * hh) : 0.f; }
                y[j] = bf2f(row[PC_GB + c]) * a; ss += y[j] * y[j];
            }
            const float r = 1.0f / sqrtf(wave_sum(ss) * (1.0f / 256.f) + EPS);
#pragma unroll
            for (int j = 0; j < 4; ++j) { const int c = lane + 64 * j; F_GROUPS[(size_t)m * D + 256 + c] = (bf16)f2bf(y[j] * r * bnw[256 + c]); }
        }
    }
}

__device__ __forceinline__ void x2_ssd_naive(Frame& F, int l, int b, int h, int p) {
    const int lane = F.lane, g = h >> 1;
    const bf16* P = F_PROJ + (size_t)b * SEQ * NPROJ;
    const int chx = h * 64 + p, chB0 = 256 + g * 128 + lane, chB1 = chB0 + 64, chC0 = 512 + g * 128 + lane, chC1 = chC0 + 64;
    const float* cw = FIN(I_SSDCW) + (size_t)l * 4 * 768; const float* cb = FIN(I_SSDCB) + (size_t)l * 768;
    float wx[4], wB0[4], wB1[4], wC0[4], wC1[4];
#pragma unroll
    for (int k = 0; k < 4; ++k) { wx[k] = cw[k * 768 + chx]; wB0[k] = cw[k * 768 + chB0]; wB1[k] = cw[k * 768 + chB1]; wC0[k] = cw[k * 768 + chC0]; wC1[k] = cw[k * 768 + chC1]; }
    const float bx = cb[chx], bB0 = cb[chB0], bB1 = cb[chB1], bC0 = cb[chC0], bC1 = cb[chC1];
    const float dtb = FIN(I_DTB)[l * 4 + h], a = -__expf(FIN(I_ALOG)[l * 4 + h]), Dk = FIN(I_SSDD)[l * 4 + h];
    float x1 = 0.f, x2 = 0.f, x3 = 0.f, p1 = 0.f, p2 = 0.f, p3 = 0.f, q1 = 0.f, q2 = 0.f, q3 = 0.f, r1 = 0.f, r2 = 0.f, r3 = 0.f, s1 = 0.f, s2 = 0.f, s3 = 0.f;
    float st0 = 0.f, st1 = 0.f;
    const float* DTp = F_DT + (size_t)b * SEQ * 4 + h; float* Yo = F_YC + (size_t)b * SEQ * 256 + h * 64 + p;
    for (int t0 = 0; t0 < SEQ; t0 += 8) {
        float rx[8], rB0[8], rB1[8], rC0[8], rC1[8], rz[8], rdt[8], yv[8];
#pragma unroll
        for (int i = 0; i < 8; ++i) { const bf16* row = P + (size_t)(t0 + i) * NPROJ;
            rx[i] = bf2f(row[PC_X + chx]); rB0[i] = bf2f(row[PC_X + chB0]); rB1[i] = bf2f(row[PC_X + chB1]); rC0[i] = bf2f(row[PC_X + chC0]); rC1[i] = bf2f(row[PC_X + chC1]);
            rz[i] = bf2f(row[PC_Z + chx]); rdt[i] = DTp[(size_t)(t0 + i) * 4]; }
#pragma unroll
        for (int i = 0; i < 8; ++i) {
            const float xc = wx[3] * rx[i] + wx[2] * x1 + wx[1] * x2 + wx[0] * x3 + bx; x3 = x2; x2 = x1; x1 = rx[i];
            const float b0 = wB0[3] * rB0[i] + wB0[2] * p1 + wB0[1] * p2 + wB0[0] * p3 + bB0; p3 = p2; p2 = p1; p1 = rB0[i];
            const float b1 = wB1[3] * rB1[i] + wB1[2] * q1 + wB1[1] * q2 + wB1[0] * q3 + bB1; q3 = q2; q2 = q1; q1 = rB1[i];
            const float c0 = wC0[3] * rC0[i] + wC0[2] * r1 + wC0[1] * r2 + wC0[0] * r3 + bC0; r3 = r2; r2 = r1; r1 = rC0[i];
            const float c1 = wC1[3] * rC1[i] + wC1[2] * s1 + wC1[1] * s2 + wC1[0] * s3 + bC1; s3 = s2; s2 = s1; s1 = rC1[i];
            const float xs = siluf(xc), B0 = siluf(b0), B1 = siluf(b1), C0 = siluf(c0), C1 = siluf(c1);
            const float dt = softplusf(rdt[i] + dtb), dA = __expf(dt * a), xdt = xs * dt;
            st0 = st0 * dA + xdt * B0; st1 = st1 * dA + xdt * B1;
            const float y = wave_sum(C0 * st0 + C1 * st1);
            yv[i] = (y + Dk * xs) * siluf(rz[i]);
        }
        if (lane == 0) {
#pragma unroll
            for (int i = 0; i < 8; ++i) Yo[(size_t)(t0 + i) * 256] = yv[i];
        }
    }
}

__device__ __forceinline__ void x2_s5_naive(Frame& F, int l, int b, int g) {
    const int lane = F.lane; const int lg = l * 16 + g;
    const float are = FIN(I_S5ARE)[lg * 64 + lane], aim = FIN(I_S5AIM)[lg * 64 + lane], step = expf(FIN(I_S5LS)[lg]);
    const float mag = expf(are * step), lr = mag * cosf(aim * step), li = mag * sinf(aim * step);
    const float den = are * are + aim * aim, nr = lr - 1.0f, fre = (nr * are + li * aim) / den, fim = (li * are - nr * aim) / den;
    float bbr[16], bbi[16], cre[16], cim[16];
#pragma unroll
    for (int h = 0; h < 16; ++h) { const float br = FIN(I_S5BRE)[((size_t)lg * 64 + lane) * 16 + h], bi = FIN(I_S5BIM)[((size_t)lg * 64 + lane) * 16 + h];
        bbr[h] = fre * br - fim * bi; bbi[h] = fre * bi + fim * br;
        cre[h] = FIN(I_S5CRE)[((size_t)lg * 16 + h) * 64 + lane]; cim[h] = FIN(I_S5CIM)[((size_t)lg * 16 + h) * 64 + lane]; }
    const float dsk = FIN(I_S5D)[l * 256 + g * 16 + (lane & 15)];
    const bf16* P = F_PROJ + (size_t)b * SEQ * NPROJ + PC_S5 + g * 16; float* Yo = F_YS + (size_t)b * SEQ * 256 + g * 16 + (lane & 15);
    float sre = 0.f, sim = 0.f;
    for (int t0 = 0; t0 < SEQ; t0 += 4) {
        v4u ua[4], ub[4]; float ul[4], yo[4];
#pragma unroll
        for (int i = 0; i < 4; ++i) { const bf16* row = P + (size_t)(t0 + i) * NPROJ; ua[i] = *(const v4u*)row; ub[i] = *(const v4u*)(row + 8); ul[i] = bf2f(row[lane & 15]); }
#pragma unroll
        for (int i = 0; i < 4; ++i) {
            float u[16];
#pragma unroll
            for (int e = 0; e < 4; ++e) { u[2 * e] = __uint_as_float(ua[i][e] << 16); u[2 * e + 1] = __uint_as_float(ua[i][e] & 0xffff0000u);
                                          u[8 + 2 * e] = __uint_as_float(ub[i][e] << 16); u[8 + 2 * e + 1] = __uint_as_float(ub[i][e] & 0xffff0000u); }
            float bur = 0.f, bui = 0.f;
#pragma unroll
            for (int h = 0; h < 16; ++h) { bur += bbr[h] * u[h]; bui += bbi[h] * u[h]; }
            const float nre = lr * sre - li * sim + bur, nim = lr * sim + li * sre + bui; sre = nre; sim = nim;
            float v[16];
#pragma unroll
            for (int h = 0; h < 16; ++h) v[h] = sre * cre[h] - sim * cim[h];
#pragma unroll
            for (int i2 = 0; i2 < 8; ++i2) { const bool up = lane & 1; const float a_ = v[2 * i2], b_ = v[2 * i2 + 1]; const float rcv = __shfl_xor(up ? a_ : b_, 1); v[i2] = (up ? b_ : a_) + rcv; }
#pragma unroll
            for (int i2 = 0; i2 < 4; ++i2) { const bool up = lane & 2; const float a_ = v[2 * i2], b_ = v[2 * i2 + 1]; const float rcv = __shfl_xor(up ? a_ : b_, 2); v[i2] = (up ? b_ : a_) + rcv; }
#pragma unroll
            for (int i2 = 0; i2 < 2; ++i2) { const bool up = lane & 4; const float a_ = v[2 * i2], b_ = v[2 * i2 + 1]; const float rcv = __shfl_xor(up ? a_ : b_, 4); v[i2] = (up ? b_ : a_) + rcv; }
            { const bool up = lane & 8; const float a_ = v[0], b_ = v[1]; const float rcv = __shfl_xor(up ? a_ : b_, 8); v[0] = (up ? b_ : a_) + rcv; }
            float y = v[0]; y += __shfl_xor(y, 16); y += __shfl_xor(y, 32);
            yo[i] = y + dsk * ul[i];
        }
        if (lane < 16) {
#pragma unroll
            for (int i = 0; i < 4; ++i) Yo[(size_t)(t0 + i) * 256] = yo[i];
        }
    }
}

__device__ __forceinline__ void x3_post(Frame& F, int l) {
    const int gw = F.vcu * NWAVES + F.wave, NGW = F.G * NWAVES, lane = F.lane;
    LAS float* gs = (LAS float*)(F.lds + RING_OFF + F.wave * 16384);
    const float* bnw = FIN(I_BNW) + l * D; const float* gwt = FIN(I_GLUW) + (size_t)l * 256 * 256; const float* gbias = FIN(I_GLUB) + l * 256;
    for (int blk = gw; blk < M / 8; blk += NGW) {
        const int m0 = blk * 8;
        for (int tok = 0; tok < 8; ++tok) {
            const int m = m0 + tok; float y[4], ss = 0.f;
#pragma unroll
            for (int j = 0; j < 4; ++j) { y[j] = F_YC[(size_t)m * 256 + lane + 64 * j]; ss += y[j] * y[j]; }
            const float r = 1.0f / sqrtf(wave_sum(ss) * (1.0f / 256.f) + EPS);
#pragma unroll
            for (int j = 0; j < 4; ++j) { const int c = lane + 64 * j; F_GROUPS[(size_t)m * D + 512 + c] = (bf16)f2bf(y[j] * r * bnw[512 + c]); }
#pragma unroll
            for (int j = 0; j < 4; ++j) gs[tok * 256 + lane + 64 * j] = gelu_tanh(F_YS[(size_t)m * 256 + lane + 64 * j]);
        }
        LDS_WAIT(); asm volatile("" ::: "memory");
        float acc[8][4];
#pragma unroll
        for (int tok = 0; tok < 8; ++tok)
#pragma unroll
            for (int j = 0; j < 4; ++j) acc[tok][j] = 0.f;
        for (int c = 0; c < 256; ++c) {
            float w[4];
#pragma unroll
            for (int j = 0; j < 4; ++j) w[j] = gwt[(size_t)c * 256 + lane + 64 * j];
#pragma unroll
            for (int tok = 0; tok < 8; ++tok) { const float gv = gs[tok * 256 + c];
#pragma unroll
                for (int j = 0; j < 4; ++j) acc[tok][j] += gv * w[j]; }
        }
#pragma unroll
        for (int tok = 0; tok < 8; ++tok) {
            const int m = m0 + tok; float y[4], ss = 0.f;
#pragma unroll
            for (int j = 0; j < 4; ++j) { const float gv = gs[tok * 256 + lane + 64 * j]; y[j] = gv * sigmf(acc[tok][j] + gbias[lane + 64 * j]); ss += y[j] * y[j]; }
            const float r = 1.0f / sqrtf(wave_sum(ss) * (1.0f / 256.f) + EPS);
#pragma unroll
            for (int j = 0; j < 4; ++j) { const int c = lane + 64 * j; F_GROUPS[(size_t)m * D + 768 + c] = (bf16)f2bf(y[j] * r * bnw[768 + c]); }
        }
        LDS_WAIT(); asm volatile("" ::: "memory");
    }
}

template <int l> __device__ __forceinline__ void layer_body(Frame& F, const XcdBarrier& bar) {
#define GRID_BAR() xcd_barrier(bar)
        const float* hsrc = (l == 0) ? FIN(I_X) : F_H;
    norm_phase(F, hsrc, FIN(I_NMIX) + l * D, l, 0, 1, F_UV, true);
    GRID_BAR();
    { pg8::Gemm g{F_UV, F_WinT + (size_t)l * NPROJ * D, M, NPROJ, D}; pg8::StaticOrder S; S.init(M, NPROJ, F.G, (int)blockIdx.x);
      pg8::EpiBf16<0> E{F_PROJ, NPROJ};
      pg8::gemm_phase<pg8::EpiBf16<0>, pg8::StaticOrder, true, true>(F.lds + RING_OFF, g, S, E); }
    GRID_BAR();
    { const int r = F.wave * F.G + F.vcu;
      if (r < 512) x2_ssd_naive(F, l, r >> 8, (r >> 6) & 3, r & 63);
      else if (r < 544) x2_s5_naive(F, l, (r - 512) >> 4, (r - 512) & 15);
      x1_pool_sconv(F, l); }
    GRID_BAR();
    x3_post(F, l);
    GRID_BAR();
    { pg8::Gemm g{F_GROUPS, F_WoutT + (size_t)l * D * D, M, D, D}; pg8::StaticOrder S; S.init(M, D, F.G, (int)blockIdx.x);
      pg8::EpiResGate E{hsrc, F_H, D, F_MODP + (size_t)l * 2 * MOD + 2 * D, FIN(I_ADAB) + (size_t)l * MOD + 2 * D, 2 * 2 * MOD, MOD, SEQ};
      pg8::gemm_phase<pg8::EpiResGate, pg8::StaticOrder, true, true>(F.lds + RING_OFF, g, S, E); }
    GRID_BAR();
    norm_phase(F, F_H, FIN(I_NMLP) + l * D, l, 3, 4, F_UV, false);
    GRID_BAR();
    { pg8::Gemm g{F_UV, F_W1T + (size_t)l * FF * D, M, FF, D}; pg8::StaticOrder S; S.init(M, FF, F.G, (int)blockIdx.x);
      pg8::EpiBf16<2> E{F_HID, FF};
      pg8::gemm_phase<pg8::EpiBf16<2>, pg8::StaticOrder, true, true>(F.lds + RING_OFF, g, S, E); }
    GRID_BAR();
    { pg8::Gemm g{F_HID, F_W2T + (size_t)l * D * FF, M, D, FF}; pg8::StaticOrder S; S.init(M, D, F.G, (int)blockIdx.x);
      pg8::EpiResGate E{F_H, F_H, D, F_MODP + (size_t)l * 2 * MOD + 5 * D, FIN(I_ADAB) + (size_t)l * MOD + 5 * D, 2 * 2 * MOD, MOD, SEQ};
      pg8::gemm_phase<pg8::EpiResGate, pg8::StaticOrder, true, true>(F.lds + RING_OFF, g, S, E); }
    GRID_BAR();
}

struct Args { const float* in[N_IN]; float* out; unsigned char* ws; };
__global__ void __launch_bounds__(NWAVES * 64, 2) mk_fwd(Args args_unused) {
    extern __shared__ __attribute__((aligned(16))) unsigned char lds[];
    Frame F;
    F.lds = (LAS unsigned char*)lds;
    F.MISC = (volatile LAS unsigned*)(F.lds + MISC_OFF);
    F.tid = threadIdx.x; F.lane = F.tid & 63; F.wave = __builtin_amdgcn_readfirstlane(F.tid >> 6);
    F.G = gridDim.x; { const int bx = blockIdx.x; F.vcu = (F.G % 8 == 0) ? (bx % 8) * (F.G / 8) + bx / 8 : bx; }
    F.karg = (const __attribute__((address_space(4))) unsigned char*)__builtin_amdgcn_kernarg_segment_ptr();
    F.ws = *(unsigned char* const __attribute__((address_space(4)))*)(F.karg + 8 * (N_IN + 1));
    F.ctl = (gu32*)(F.ws + WS_CTL);
    for (int u = F.tid; u < (LDS_BYTES - LDSCTL_OFF) / 4; u += NWAVES * 64) ((LAS unsigned*)(F.lds + LDSCTL_OFF))[u] = 0u;
    __syncthreads();
    XcdBarrier bar = xcd_barrier_post((unsigned*)(F.ctl + CW_BAR), F.MISC + 8);

    p0_prologue(F);
    GRID_BAR();
    layer_body<0>(F, bar);
    layer_body<1>(F, bar);
    final_norm_phase(F);
}

extern "C" void kernel_launch(void* const* d_in, const int* in_sizes, int n_in, void* d_out, int out_size, void* d_ws, size_t ws_size, hipStream_t stream) {
    static int grid = 0;
    if (grid == 0) {
        if (n_in != N_IN || in_sizes[0] != M * D || out_size != M * D || ws_size < WS_END) { fprintf(stderr, "kernel_launch: unexpected shapes (n_in %d, in0 %d, out %d, ws %zu); nothing launched\n", n_in, n_in > 0 ? in_sizes[0] : -1, out_size, ws_size); grid = -1; return; }
        int dev = 0, cus = 0, per_cu = 0;
        if (hipGetDevice(&dev) != hipSuccess || hipDeviceGetAttribute(&cus, hipDeviceAttributeMultiprocessorCount, dev) != hipSuccess) { grid = -1; return; }
        if (hipFuncSetAttribute((const void*)mk_fwd, hipFuncAttributeMaxDynamicSharedMemorySize, LDS_BYTES) != hipSuccess) { fprintf(stderr, "kernel_launch: hipFuncSetAttribute failed\n"); grid = -1; return; }
        if (hipOccupancyMaxActiveBlocksPerMultiprocessor(&per_cu, (const void*)mk_fwd, NWAVES * 64, LDS_BYTES) != hipSuccess || per_cu < 1) fprintf(stderr, "kernel_launch: occupancy query reports %d\n", per_cu);
        (void)hipGetLastError();
        grid = cus;
    }
    if (grid < 0) return;
    if (hipMemsetAsync((char*)d_ws + WS_CTL, 0, CTL_ZERO_BYTES, stream) != hipSuccess) return;
    Args a{};
    for (int i = 0; i < N_IN; ++i) a.in[i] = (const float*)d_in[i];
    a.out = (float*)d_out; a.ws = (unsigned char*)d_ws;
    hipLaunchKernelGGL(mk_fwd, dim3(grid), dim3(NWAVES * 64), LDS_BYTES, stream, a);
}
```

```cpp
#include <hip/hip_runtime.h>
#include <cstdio>
#include <cstdint>
#include <cmath>
namespace pg8 {
#define PG8_LAS __attribute__((address_space(3)))
typedef unsigned short bf16_t;
typedef short bf16x8 __attribute__((ext_vector_type(8)));
typedef float f32x4 __attribute__((ext_vector_type(4)));
typedef unsigned u32x4 __attribute__((ext_vector_type(4)));
constexpr int BM = 256, BK = 64, HALF = 128, HTB = HALF * BK * 2  , STAGE_BYTES = 8 * HTB, NXCD = 8, WGM = 8;

__host__ __device__ __forceinline__ int lds_byte(int r, int c) { const int st = (r >> 4) * 2 + (c >> 5), rr = r & 15, cc = c & 31, ob = rr * 64 + cc * 2; return st * 1024 + (ob ^ (((ob >> 9) & 1) << 5)); }
__host__ __device__ __forceinline__ void stage_rc(int b, int& R, int& C) { const int st = b / 1024, sb = b % 1024, swz = sb ^ (((sb >> 9) & 1) << 5); R = (st >> 1) * 16 + swz / 64; C = (st & 1) * 32 + (swz % 64) / 2; }
__host__ __device__ __forceinline__ int perm32(int rho) { const int n = rho >> 4, i = rho & 15; return 8 * (i >> 2) + 4 * n + (i & 3); }

struct Unit { int pm, pn; };
struct Gemm { const bf16_t* A; const bf16_t* Bt; int M, N, K; };

struct StaticOrder {
    int nM, nN, nwg, G, c;
    __host__ __device__ void init(int M, int N, int G_, int c_) { nM = M / BM; nN = N / BM; nwg = nM * nN; G = G_; c = c_; }
    __host__ __device__ bool next(int i, Unit& u) const {
        const long L = (long)i * G + c; if (L >= nwg) return false;
        int wgid = (int)L; { const int q = nwg / NXCD, r = nwg % NXCD, xcd = wgid % NXCD, off = wgid / NXCD; wgid = (xcd < r ? xcd * (q + 1) : r * (q + 1) + (xcd - r) * q) + off; }
        const int nig = WGM * nN, gid = wgid / nig, fm = gid * WGM, gsz = (nM - fm) < WGM ? (nM - fm) : WGM;
        u.pm = fm + ((wgid % nig) % gsz); u.pn = (wgid % nig) / gsz; return true;
    }
    __device__ __forceinline__ void a_ready(const Unit&) const {}
    __device__ __forceinline__ void done(const Unit&) const {}
};


__device__ __forceinline__ unsigned cvt_pk_bf16(float lo, float hi) { unsigned r; asm volatile("v_cvt_pk_bf16_f32 %0, %1, %2" : "=v"(r) : "v"(lo), "v"(hi)); return r; }

template <int ACT> struct EpiBf16 {
    static constexpr bool PERM = true, AFTER_DRAIN = false;
    bf16_t* O; int ldc;
    __device__ __forceinline__ void operator()(const f32x4 (&acc)[2][2][4][2], const Unit& u, int wr, int wc, int fr, int fq) const {
        const int row0 = u.pm * BM + wr * 64 + fr; const int col0 = u.pn * BM + wc * 32 + 8 * fq;
#pragma unroll
        for (int ai = 0; ai < 2; ++ai)
#pragma unroll
            for (int m = 0; m < 4; ++m) { bf16_t* rowp = O + (size_t)(row0 + ai * HALF + m * 16) * ldc + col0;
#pragma unroll
                for (int bj = 0; bj < 2; ++bj) { f32x4 v0 = acc[ai][bj][m][0], v1 = acc[ai][bj][m][1];
                    if (ACT == 2) {
#pragma unroll
                        for (int e = 0; e < 4; ++e) { const float a = v0[e] > 0.f ? v0[e] : 0.f, b = v1[e] > 0.f ? v1[e] : 0.f; v0[e] = a * a; v1[e] = b * b; } }
                    u32x4 w; w.x = cvt_pk_bf16(v0[0], v0[1]); w.y = cvt_pk_bf16(v0[2], v0[3]); w.z = cvt_pk_bf16(v1[0], v1[1]); w.w = cvt_pk_bf16(v1[2], v1[3]);
                    *(u32x4*)(rowp + bj * HALF) = w; } }
    }
};
struct EpiCompact16 {
    static constexpr bool PERM = true, AFTER_DRAIN = false;
    bf16_t* O; int M2;
    __device__ __forceinline__ void operator()(const f32x4 (&acc)[2][2][4][2], const Unit& u, int wr, int wc, int fr, int fq) const {
        const int row0 = u.pm * BM + wr * 64 + fr; const int cl = wc * 32 + 8 * fq;
        bf16_t* const base = O + (size_t)(cl >> 4) * M2 * 16 + (cl & 15);
#pragma unroll
        for (int ai = 0; ai < 2; ++ai)
#pragma unroll
            for (int m = 0; m < 4; ++m) { bf16_t* rowp = base + (size_t)(row0 + ai * HALF + m * 16) * 16;
#pragma unroll
                for (int bj = 0; bj < 2; ++bj) { const f32x4 v0 = acc[ai][bj][m][0], v1 = acc[ai][bj][m][1];
                    u32x4 w; w.x = cvt_pk_bf16(v0[0], v0[1]); w.y = cvt_pk_bf16(v0[2], v0[3]); w.z = cvt_pk_bf16(v1[0], v1[1]); w.w = cvt_pk_bf16(v1[2], v1[3]);
                    *(u32x4*)(rowp + (size_t)bj * 8 * M2 * 16) = w; } }
    }
};

struct EpiResGate {
    static constexpr bool PERM = false, AFTER_DRAIN = false;
    const float* base; float* out; int ldc; const float* gp; const float* gb; int gps, gbs, rows_per_batch;
    __device__ __forceinline__ void operator()(const f32x4 (&acc)[2][2][4][2], const Unit& u, int wr, int wc, int fr, int fq) const {
        const int col0 = u.pn * BM + wc * 32 + 4 * fq; const int b = (u.pm * BM) / rows_per_batch;
        f32x4 gv[2][2];
#pragma unroll
        for (int bj = 0; bj < 2; ++bj)
#pragma unroll
            for (int n = 0; n < 2; ++n) { const int c = col0 + bj * HALF + n * 16; const float* q = gp + (size_t)b * gbs + c;
                gv[bj][n] = *(const f32x4*)(gb + c) + ((*(const f32x4*)(q) + *(const f32x4*)(q + gps)) + (*(const f32x4*)(q + 2 * (size_t)gps) + *(const f32x4*)(q + 3 * (size_t)gps))); }
#pragma unroll
        for (int ai = 0; ai < 2; ++ai)
#pragma unroll
            for (int m = 0; m < 4; ++m) { const size_t off = (size_t)(u.pm * BM + ai * HALF + wr * 64 + m * 16 + fr) * ldc + col0;
#pragma unroll
                for (int bj = 0; bj < 2; ++bj)
#pragma unroll
                    for (int n = 0; n < 2; ++n) { const f32x4 bs = *(const f32x4*)(base + off + bj * HALF + n * 16);
                        *(f32x4*)(out + off + bj * HALF + n * 16) = bs + gv[bj][n] * acc[ai][bj][m][n]; }
                if (m & 1) asm volatile("" ::: "memory"); }
    }
};

template <class Epi, class Sched, bool ALIGN_EPI = false, bool SP2 = false>
__device__ __forceinline__ void gemm_phase(PG8_LAS unsigned char* lds, const Gemm g, const Sched& S, const Epi& E) {
    const int tid = threadIdx.x, wid = __builtin_amdgcn_readfirstlane(tid >> 6), lane = tid & 63, wr = wid >> 2, wc = wid & 3, fr = lane & 15, fq = lane >> 4;
    const int K = g.K, nt = K / BK;
    unsigned voffA[2], voffB[2];
#pragma unroll
    for (int i = 0; i < 2; ++i) { int R, C; stage_rc(tid * 16 + i * 8192, R, C); const int Rb = Epi::PERM ? ((R & ~31) + perm32(R & 31)) : R;
        voffA[i] = (unsigned)(R * K + C) * 2u; voffB[i] = (unsigned)(Rb * K + C) * 2u; }
    const size_t kstep = (size_t)(BK * 2);
    const size_t hstep = (size_t)HALF * K * 2;
    const size_t tstep = 2 * hstep;
    const unsigned ldsw = (unsigned)wid * 1024u;
    const int aoff = lds_byte(wr * 64 + fr, fq * 8), boff = lds_byte(wc * 32 + fr, fq * 8);
#define PG8_SA(b, h) (((b) * 2 + (h)) * HTB)
#define PG8_SB(b, h) ((4 + (b) * 2 + (h)) * HTB)
#define PG8_STAGE(bufoff, gbase, voff) do { _Pragma("unroll") for (int _i = 0; _i < 2; ++_i) \
        __builtin_amdgcn_global_load_lds((const unsigned*)((const char*)(gbase) + (voff)[_i]), (PG8_LAS unsigned*)(lds + (bufoff) + ldsw + _i * 8192), 16, 0, 0); } while (0)
#define PG8_LDA(dst, b, h) do { _Pragma("unroll") for (int m = 0; m < 4; ++m) _Pragma("unroll") for (int k = 0; k < 2; ++k) dst[m][k] = *(const PG8_LAS bf16x8*)(lds + PG8_SA(b, h) + aoff + m * 2048 + k * 1024); } while (0)
#define PG8_LDB(dst, b, h) do { _Pragma("unroll") for (int n = 0; n < 2; ++n) _Pragma("unroll") for (int k = 0; k < 2; ++k) dst[n][k] = *(const PG8_LAS bf16x8*)(lds + PG8_SB(b, h) + boff + n * 2048 + k * 1024); } while (0)
#define PG8_MMA(ai, bj, At, Bt) do { __builtin_amdgcn_s_setprio(1); _Pragma("unroll") for (int m = 0; m < 4; ++m) _Pragma("unroll") for (int n = 0; n < 2; ++n) _Pragma("unroll") for (int k = 0; k < 2; ++k) \
        acc[ai][bj][m][n] = __builtin_amdgcn_mfma_f32_16x16x32_bf16(Bt[n][k], At[m][k], acc[ai][bj][m][n], 0, 0, 0); __builtin_amdgcn_s_setprio(0); } while (0)
#define PG8_WAIT_V(n) asm volatile("s_waitcnt vmcnt(" #n ")" ::: "memory")
#define PG8_WAIT_L(n) asm volatile("s_waitcnt lgkmcnt(" #n ")" ::: "memory")
#define PG8_BAR __builtin_amdgcn_s_barrier()
#define PG8_SCHED __builtin_amdgcn_sched_barrier(0)
    Unit cur, nxt; int ui = 0;
    if (!S.next(0, cur)) return;
    f32x4 acc[2][2][4][2];
#pragma unroll
    for (int a = 0; a < 2; ++a)
#pragma unroll
        for (int b = 0; b < 2; ++b)
#pragma unroll
            for (int m = 0; m < 4; ++m)
#pragma unroll
                for (int n = 0; n < 2; ++n) acc[a][b][m][n] = (f32x4){0.f, 0.f, 0.f, 0.f};
    bf16x8 At[4][2], B0[2][2], B1[2][2];
    const char* cA = (const char*)g.A + (size_t)cur.pm * tstep; const char* cB = (const char*)g.Bt + (size_t)cur.pn * tstep;
    S.a_ready(cur);
    if constexpr (SP2) {
        PG8_STAGE(PG8_SB(0, 0), cB, voffB); PG8_STAGE(PG8_SB(0, 1), cB + hstep, voffB); PG8_STAGE(PG8_SA(0, 0), cA, voffA); PG8_STAGE(PG8_SA(0, 1), cA + hstep, voffA);
        if (wr == 1) PG8_BAR;
        PG8_WAIT_V(2); PG8_BAR;
        PG8_STAGE(PG8_SB(1, 0), cB + kstep, voffB); PG8_STAGE(PG8_SA(1, 0), cA + kstep, voffA); PG8_STAGE(PG8_SB(1, 1), cB + hstep + kstep, voffB);
        PG8_WAIT_V(6); PG8_BAR;
    } else {
        PG8_STAGE(PG8_SB(0, 0), cB, voffB); PG8_STAGE(PG8_SA(0, 0), cA, voffA); PG8_STAGE(PG8_SB(0, 1), cB + hstep, voffB); PG8_STAGE(PG8_SA(0, 1), cA + hstep, voffA);
        if (wr == 1) PG8_BAR;
        PG8_WAIT_V(4); PG8_BAR;
        PG8_STAGE(PG8_SB(1, 0), cB + kstep, voffB); PG8_STAGE(PG8_SA(1, 0), cA + kstep, voffA); PG8_STAGE(PG8_SB(1, 1), cB + hstep + kstep, voffB);
        PG8_WAIT_V(6); PG8_BAR;
    }
    for (;;) {
        const bool has_next = S.next(ui + 1, nxt);
        const char* nA = has_next ? (const char*)g.A + (size_t)nxt.pm * tstep : cA; const char* nB = has_next ? (const char*)g.Bt + (size_t)nxt.pn * tstep : cB;
        for (int t = 0; t < nt; t += 2) {
            const bool last = (t == nt - 2);
            const char* a1 = cA + (size_t)(t + 1) * kstep;
            const char* a2 = last ? nA : cA + (size_t)(t + 2) * kstep; const char* b2 = last ? nB : cB + (size_t)(t + 2) * kstep;
            const char* a3 = a2 + kstep; const char* b3 = b2 + kstep;
            if (last && has_next) S.a_ready(nxt);
            if constexpr (SP2) {
            PG8_LDB(B0, 0, 0); PG8_LDB(B1, 0, 1); PG8_SCHED; PG8_LDA(At, 0, 0); PG8_STAGE(PG8_SA(1, 1), a1 + hstep, voffA);
            PG8_WAIT_V(8); PG8_WAIT_L(0); PG8_BAR; PG8_MMA(0, 0, At, B0); PG8_MMA(0, 1, At, B1); PG8_BAR; PG8_SCHED;
            PG8_LDA(At, 0, 1); PG8_STAGE(PG8_SB(0, 0), b2, voffB); PG8_STAGE(PG8_SB(0, 1), b2 + hstep, voffB); PG8_STAGE(PG8_SA(0, 0), a2, voffA);
            PG8_WAIT_V(8); PG8_WAIT_L(0); PG8_BAR; PG8_MMA(1, 0, At, B0); PG8_MMA(1, 1, At, B1); PG8_BAR; PG8_SCHED;
            PG8_LDB(B0, 1, 0); PG8_LDB(B1, 1, 1); PG8_SCHED; PG8_LDA(At, 1, 0); PG8_STAGE(PG8_SA(0, 1), a2 + hstep, voffA);
            PG8_WAIT_V(8); PG8_WAIT_L(0); PG8_BAR; PG8_MMA(0, 0, At, B0); PG8_MMA(0, 1, At, B1); PG8_BAR; PG8_SCHED;
            PG8_LDA(At, 1, 1); PG8_STAGE(PG8_SB(1, 0), b3, voffB); PG8_STAGE(PG8_SB(1, 1), b3 + hstep, voffB); PG8_STAGE(PG8_SA(1, 0), a3, voffA);
            PG8_WAIT_V(8); PG8_WAIT_L(0); PG8_BAR; PG8_MMA(1, 0, At, B0); PG8_MMA(1, 1, At, B1); PG8_BAR; PG8_SCHED;
            } else {
            PG8_LDB(B0, 0, 0); PG8_SCHED; PG8_LDA(At, 0, 0); PG8_STAGE(PG8_SA(1, 1), a1 + hstep, voffA);
            PG8_WAIT_L(8); PG8_BAR; PG8_WAIT_L(0); PG8_MMA(0, 0, At, B0); PG8_BAR; PG8_SCHED;
            PG8_LDB(B1, 0, 1); PG8_STAGE(PG8_SB(0, 0), b2, voffB);
            PG8_BAR; PG8_WAIT_L(0); PG8_MMA(0, 1, At, B1); PG8_BAR;
            PG8_LDA(At, 0, 1); PG8_STAGE(PG8_SA(0, 0), a2, voffA);
            PG8_BAR; PG8_WAIT_L(0); PG8_MMA(1, 0, At, B0); PG8_BAR; PG8_SCHED;
            PG8_STAGE(PG8_SB(0, 1), b2 + hstep, voffB);
            PG8_WAIT_V(6); PG8_BAR; PG8_MMA(1, 1, At, B1); PG8_BAR;
            PG8_LDB(B0, 1, 0); PG8_SCHED; PG8_LDA(At, 1, 0); PG8_STAGE(PG8_SA(0, 1), a2 + hstep, voffA);
            PG8_WAIT_L(8); PG8_BAR; PG8_WAIT_L(0); PG8_MMA(0, 0, At, B0); PG8_BAR; PG8_SCHED;
            PG8_LDB(B1, 1, 1); PG8_STAGE(PG8_SB(1, 0), b3, voffB);
            PG8_BAR; PG8_WAIT_L(0); PG8_MMA(0, 1, At, B1); PG8_BAR;
            PG8_LDA(At, 1, 1); PG8_STAGE(PG8_SA(1, 0), a3, voffA);
            PG8_BAR; PG8_WAIT_L(0); PG8_MMA(1, 0, At, B0); PG8_BAR; PG8_SCHED;
            PG8_STAGE(PG8_SB(1, 1), b3 + hstep, voffB);
            PG8_WAIT_V(6); PG8_BAR; PG8_MMA(1, 1, At, B1); PG8_BAR;
            }
        }
        if constexpr (ALIGN_EPI) { if (wr == 0) PG8_BAR; }
        if constexpr (!Epi::AFTER_DRAIN) { E(acc, cur, wr, wc, fr, fq); S.done(cur); }
        if (!has_next) break;
#pragma unroll
        for (int a = 0; a < 2; ++a)
#pragma unroll
            for (int b = 0; b < 2; ++b)
#pragma unroll
                for (int m = 0; m < 4; ++m)
#pragma unroll
                    for (int n = 0; n < 2; ++n) acc[a][b][m][n] = (f32x4){0.f, 0.f, 0.f, 0.f};
        cur = nxt; cA = nA; cB = nB; ++ui;
        if constexpr (ALIGN_EPI) { if (wr == 1) PG8_BAR; }
    }
    PG8_WAIT_V(0);
    if constexpr (!ALIGN_EPI) { if (wr == 0) PG8_BAR; }
    PG8_BAR;
    if constexpr (Epi::AFTER_DRAIN) { E.fused(acc, cur, wr, wc, fr, fq, lds, wid, lane); S.done(cur); }
#undef PG8_SA
#undef PG8_SB
#undef PG8_STAGE
#undef PG8_LDA
#undef PG8_LDB
#undef PG8_MMA
#undef PG8_WAIT_V
#undef PG8_WAIT_L
#undef PG8_BAR
#undef PG8_SCHED
}
}

constexpr int NWAVES = 8;
constexpr int S5L = 64, NCHR = 256  ;
constexpr int BATCH = 2, SEQ = 8192, D = 1024, M = BATCH * SEQ, DEPTH = 2;
constexpr int NPROJ_SRC = 2308, NPROJ = 2304, NPP = 2048  , FF = 4096, MOD = 6 * D;
constexpr float EPS = 1e-6f;
constexpr int PC_POOL = 0, PC_GB = 256, PC_GC = 512, PC_H = 768, PC_Z = 1024, PC_X = 1280, PC_B = 1536, PC_C = 1792, PC_S5 = 2048;
enum { I_X = 0, I_C, I_NMIX, I_NMLP, I_ADAW, I_ADAB, I_WIN, I_POOLW, I_POOLS, I_SCONVW, I_SSDCW, I_SSDCB, I_DTB, I_ALOG, I_SSDD, I_S5ARE, I_S5AIM, I_S5LS, I_S5BRE, I_S5BIM,
       I_S5CRE, I_S5CIM, I_S5D, I_GLUW, I_GLUB, I_BNW, I_WOUT, I_W1, I_W2, I_FNW, N_IN };

constexpr size_t MiB = 1u << 20;
constexpr size_t WS_CTL = 0, CTL_ZERO_BYTES = 1 * MiB;
constexpr size_t WS_WIN = 1 * MiB;
constexpr size_t WS_WOUT = 10 * MiB;
constexpr size_t WS_W1 = 14 * MiB;
constexpr size_t WS_W2 = 30 * MiB;
constexpr size_t WS_UV = 46 * MiB;
constexpr size_t WS_ST = WS_UV;
constexpr size_t WS_PREV = WS_UV + 16 * MiB;
constexpr size_t WS_SEND = WS_UV + 24 * MiB;
constexpr size_t WS_ACS = WS_UV + 26 * MiB;
constexpr size_t WS_PROJ = 78 * MiB;
constexpr size_t WS_GROUPS = 142 * MiB;
constexpr size_t WS_YC = 174 * MiB;
constexpr size_t WS_YS = 190 * MiB;
constexpr size_t WS_HID = 78 * MiB;
constexpr size_t WS_MODP = 206 * MiB;
constexpr size_t WS_DT = 207 * MiB;
constexpr size_t WS_WDT = 207 * MiB + 512 * 1024;
constexpr size_t WS_PT = 208 * MiB;
constexpr size_t WS_QT = 216 * MiB;
constexpr size_t WS_KT = 224 * MiB;
constexpr size_t WS_US5 = 225 * MiB;
constexpr size_t WS_XS = 233 * MiB;
constexpr size_t WS_CS = 241 * MiB;
constexpr size_t WS_END = 249 * MiB;
constexpr int CW_BAR = 4096;

constexpr int RING_OFF = 0, RING_BYTES = 131072;
constexpr int LDS_BYTES = 147456;
constexpr int LDSCTL_OFF = LDS_BYTES - 512, MISC_OFF = LDSCTL_OFF + 320;
#define GAS __attribute__((address_space(1)))
#define LAS __attribute__((address_space(3)))
typedef unsigned short bf16;
typedef unsigned v4u __attribute__((ext_vector_type(4)));
typedef float f32x4 __attribute__((ext_vector_type(4)));
typedef short bf16x8 __attribute__((ext_vector_type(8)));
typedef GAS unsigned gu32;
typedef GAS unsigned long long gu64;
#define RLX_AGENT __ATOMIC_RELAXED, __HIP_MEMORY_SCOPE_AGENT
#define LDS_WAIT() asm volatile("s_waitcnt lgkmcnt(0)" ::: "memory")
#define VM_WAIT() asm volatile("s_waitcnt vmcnt(0)" ::: "memory")
__device__ __forceinline__ unsigned long long rt() { return __builtin_amdgcn_s_memrealtime(); }
__device__ __forceinline__ unsigned f2bf(float f) { unsigned u = __builtin_bit_cast(unsigned, f); return (u + 0x7fffu + ((u >> 16) & 1u)) >> 16; }
__device__ __forceinline__ unsigned pk2(float lo, float hi) { return f2bf(lo) | (f2bf(hi) << 16); }

#define XB_TMO      128
#define XB_XCNT(j)  (256  + 64 * (j))
#define XB_XSUB(j)  (1280 + 64 * (j))
#define XB_XGEN(j)  (2304 + 64 * (j))
#define XB_TOP      3328
#define XB_TOPGEN   3392
#define XCD_BAR_WORDS 3456
#define XB_SPIN_CAP (1u << 18)

__device__ __forceinline__ unsigned xb_ld(unsigned* p)              { return __hip_atomic_load(p, __ATOMIC_RELAXED, __HIP_MEMORY_SCOPE_AGENT); }
__device__ __forceinline__ unsigned xb_add(unsigned* p, unsigned v) { return __hip_atomic_fetch_add(p, v, __ATOMIC_RELAXED, __HIP_MEMORY_SCOPE_AGENT); }
__device__ __forceinline__ unsigned xb_xcc_id() { return (unsigned)__builtin_amdgcn_s_getreg((3 << 11) | 20) & 0xFu; }
#define XB_SPIN(cond, bar) do { unsigned _sp = 0; while (cond) { __builtin_amdgcn_s_sleep(1); \
    if ((++_sp & 255u) == 0u) { if (xb_ld(&(bar)[XB_TMO])) break; if (_sp > XB_SPIN_CAP) { atomicAdd(&(bar)[XB_TMO], 1u); break; } } } } while (0)

struct XcdBarrier {
    unsigned* bar; unsigned x;
    volatile LAS unsigned* st;
};

__device__ __forceinline__ XcdBarrier xcd_barrier_post(unsigned* bar, volatile LAS unsigned* st) {
    XcdBarrier b; b.bar = bar; b.x = xb_xcc_id(); b.st = st;
    if (threadIdx.x == 0) (void)xb_add(&bar[XB_XCNT(b.x)], 1u);
    return b;
}
__device__ __forceinline__ void xcd_barrier_complete(unsigned* bar, unsigned x, unsigned& nloc, unsigned& nx) {
    const unsigned G = gridDim.x * gridDim.y * gridDim.z;
    unsigned sum, cnt, mine, sp = 0u;
    for (;;) {
        sum = 0u; cnt = 0u; mine = 0u;
#pragma unroll
        for (unsigned j = 0; j < 16; ++j) { const unsigned c = xb_ld(&bar[XB_XCNT(j)]); sum += c; cnt += (c > 0u) ? 1u : 0u; mine = (j == x) ? c : mine; }
        if (sum == G) break;
        __builtin_amdgcn_s_sleep(1);
        if ((++sp & 255u) == 0u) { if (xb_ld(&bar[XB_TMO])) break; if (sp > XB_SPIN_CAP) { atomicAdd(&bar[XB_TMO], 1u); break; } }
    }
    nloc = mine > 0u ? mine : 1u; nx = cnt > 0u ? cnt : 1u;
}

__device__ __forceinline__ void xcd_barrier(const XcdBarrier& b) {
    asm volatile("s_waitcnt vmcnt(0)" ::: "memory");
    __syncthreads();
    if (threadIdx.x == 0) {
        unsigned* bar = b.bar; asm volatile("" : "+s"(bar));
        __builtin_amdgcn_s_waitcnt(0);
        unsigned nloc = b.st[0], nx = b.st[1];
        if (nloc == 0u) { xcd_barrier_complete(bar, b.x, nloc, nx); b.st[0] = nloc; b.st[1] = nx; }
        const unsigned old = xb_add(&bar[XB_XSUB(b.x)], 1u);
        const unsigned gen = old / nloc;
        if (old + 1u == (gen + 1u) * nloc) {
            __builtin_amdgcn_fence(__ATOMIC_RELEASE, "agent");
            asm volatile("s_waitcnt vmcnt(0)" ::: "memory");
            const unsigned og = xb_add(&bar[XB_TOP], 1u);
            const unsigned tg = og / nx;
            if (og + 1u == (tg + 1u) * nx) xb_add(&bar[XB_TOPGEN], 1u);
            else XB_SPIN(xb_ld(&bar[XB_TOPGEN]) == tg, bar);
            __builtin_amdgcn_fence(__ATOMIC_ACQUIRE, "agent");
            xb_add(&bar[XB_XGEN(b.x)], 1u);
            asm volatile("s_waitcnt vmcnt(0)" ::: "memory");
        } else {
            XB_SPIN(xb_ld(&bar[XB_XGEN(b.x)]) == gen, bar);
            __builtin_amdgcn_fence(__ATOMIC_ACQUIRE, "agent");
            asm volatile("s_waitcnt vmcnt(0)" ::: "memory");
        }
    }
    __syncthreads();
}

struct Frame {
    LAS unsigned char* lds;
    volatile LAS unsigned* MISC;
    gu32* ctl;
    int tid, lane, wave;
    int vcu, G;
    const __attribute__((address_space(4))) unsigned char* karg;
    unsigned char* ws;
};
#define FIN(i) (*(const float* const __attribute__((address_space(4)))*)(F.karg + 8 * (i)))
#define F_H (*(float* const __attribute__((address_space(4)))*)(F.karg + 8 * N_IN))
#define F_WinT ((bf16*)(F.ws + WS_WIN))
#define F_WoutT ((bf16*)(F.ws + WS_WOUT))
#define F_W1T ((bf16*)(F.ws + WS_W1))
#define F_W2T ((bf16*)(F.ws + WS_W2))
#define F_UV ((bf16*)(F.ws + WS_UV))
#define F_PROJ ((bf16*)(F.ws + WS_PROJ))
#define F_GROUPS ((bf16*)(F.ws + WS_GROUPS))
#define F_HID ((bf16*)(F.ws + WS_HID))
#define F_YC ((float*)(F.ws + WS_YC))
#define F_YS ((float*)(F.ws + WS_YS))
#define F_MODP ((float*)(F.ws + WS_MODP))
#define F_DT ((float*)(F.ws + WS_DT))
#define F_WDT ((float*)(F.ws + WS_WDT))
#define F_PT ((bf16*)(F.ws + WS_PT))
#define F_QT ((bf16*)(F.ws + WS_QT))
#define F_KT ((bf16*)(F.ws + WS_KT))
#define F_US5 ((bf16*)(F.ws + WS_US5))
#define F_SEND ((float*)(F.ws + WS_SEND))
#define F_ST ((float*)(F.ws + WS_ST))
#define F_PREV ((bf16*)(F.ws + WS_PREV))
#define F_ACS ((float*)(F.ws + WS_ACS))
#define F_XS ((bf16*)(F.ws + WS_XS))
#define F_CS ((bf16*)(F.ws + WS_CS))

__device__ __forceinline__ float wave_sum(float v) {
#pragma unroll
    for (int o = 1; o < 64; o <<= 1) v += __shfl_xor(v, o);
    return v;
}
__device__ __forceinline__ float bf2f(bf16 h) { return __uint_as_float(((unsigned)h) << 16); }
__device__ __forceinline__ float siluf(float x) { return x / (1.f + __expf(-x)); }
__device__ __forceinline__ float sigmf(float x) { return 1.f / (1.f + __expf(-x)); }
__device__ __forceinline__ float softplusf(float x) { return x > 20.f ? x : log1pf(__expf(x)); }
__device__ __forceinline__ float gelu_tanh(float x) { const float t = tanhf(0.7978845608028654f * (x + 0.044715f * x * x * x)); return 0.5f * x * (1.f + t); }

__device__ __forceinline__ f32x4 modv4(const Frame& F, int l, int b, int idx, int col) {
    const float* q = F_MODP + ((size_t)l * 2 + b) * MOD + idx * D + col; constexpr size_t PS = (size_t)2 * 2 * MOD;
    return *(const f32x4*)(FIN(I_ADAB) + (size_t)l * MOD + idx * D + col) + ((*(const f32x4*)q + *(const f32x4*)(q + PS)) + (*(const f32x4*)(q + 2 * PS) + *(const f32x4*)(q + 3 * PS)));
}

__device__ __forceinline__ void p0_transpose_item(const float* W, int K, int Nsrc, int nblk, int shift_from, int shift, bf16* WT, LAS float* scr, int item, int lane) {
    const int kb = item / nblk, nb = item % nblk, k0 = 64 * kb, n0 = 32 * nb, n0s = n0 + (n0 >= shift_from ? shift : 0);
#pragma unroll 8
    for (int i = 0; i < 32; ++i) { const int kk = 2 * i + (lane >> 5); scr[kk * 33 + (lane & 31)] = W[(size_t)(k0 + kk) * Nsrc + n0s + (lane & 31)]; }
    LDS_WAIT(); asm volatile("" ::: "memory");
    const int c = lane & 7;
#pragma unroll
    for (int j = 0; j < 4; ++j) { const int n = (lane >> 3) + 8 * j; const LAS float* s = scr + (8 * c) * 33 + n;
        v4u o; o.x = pk2(s[0 * 33], s[1 * 33]); o.y = pk2(s[2 * 33], s[3 * 33]); o.z = pk2(s[4 * 33], s[5 * 33]); o.w = pk2(s[6 * 33], s[7 * 33]);
        *(GAS v4u*)(WT + (size_t)(n0 + n) * K + k0 + 8 * c) = o; }
    LDS_WAIT(); asm volatile("" ::: "memory");
}

__device__ __forceinline__ void p0_prologue(Frame& F) {
    if (F.vcu < 192) {
        const int l = F.vcu / 96, rem = F.vcu % 96, cb = rem / 4, kq = rem % 4;
        const float* W = FIN(I_ADAW) + (size_t)l * D * MOD + cb * 256 + 4 * F.lane; const float* c = FIN(I_C);
        f32x4 a0 = {0.f, 0.f, 0.f, 0.f}, a1 = {0.f, 0.f, 0.f, 0.f};
        const int kbeg = kq * 256 + F.wave * 32;
#pragma unroll 8
        for (int k = kbeg; k < kbeg + 32; ++k) { const f32x4 w = *(const f32x4*)(W + (size_t)k * MOD); const float c0 = siluf(c[k]), c1 = siluf(c[D + k]); a0 += w * c0; a1 += w * c1; }
        LAS f32x4* red = (LAS f32x4*)(F.lds);
        red[(F.wave * 64 + F.lane) * 2 + 0] = a0; red[(F.wave * 64 + F.lane) * 2 + 1] = a1;
        __syncthreads();
        if (F.wave == 0) {
            f32x4 s0 = {0.f, 0.f, 0.f, 0.f}, s1 = {0.f, 0.f, 0.f, 0.f};
#pragma unroll
            for (int w = 0; w < 8; ++w) { s0 += red[(w * 64 + F.lane) * 2 + 0]; s1 += red[(w * 64 + F.lane) * 2 + 1]; }
            float* o = F_MODP + ((size_t)(kq * 2 + l) * 2) * MOD + cb * 256 + 4 * F.lane;
            *(f32x4*)o = s0; *(f32x4*)(o + MOD) = s1;
        }
        __syncthreads();
    }
    LAS float* scr = (LAS float*)(F.lds + RING_OFF + F.wave * 16384);
    const int gw = F.vcu * NWAVES + F.wave, NGW = F.G * NWAVES;
    for (int idx = gw * 64 + F.lane; idx < DEPTH * 16 * 64 * 64; idx += NGW * 64) {
        const int s = idx & 63, pp = (idx >> 6) & 63, lg = idx >> 12;
        const float are = FIN(I_S5ARE)[lg * 64 + pp], aim = FIN(I_S5AIM)[lg * 64 + pp], step = expf(FIN(I_S5LS)[lg]);
        const float mag = expf(are * step), lr = mag * cosf(aim * step), li = mag * sinf(aim * step);
        const float den = are * are + aim * aim, nr = lr - 1.0f, fre = (nr * are + li * aim) / den, fim = (li * are - nr * aim) / den;
        const float e1 = (float)(63 - s), m1 = expf(e1 * are * step), zr = m1 * cosf(e1 * aim * step), zi = m1 * sinf(e1 * aim * step);
        const float zfr = zr * fre - zi * fim, zfi = zr * fim + zi * fre;
        bf16* pt0 = F_PT + ((size_t)lg * 128 + 2 * pp) * 1024 + s * 16;
#pragma unroll
        for (int h = 0; h < 16; h += 2) { const float br0 = FIN(I_S5BRE)[((size_t)lg * 64 + pp) * 16 + h], bi0 = FIN(I_S5BIM)[((size_t)lg * 64 + pp) * 16 + h];
            const float br1 = FIN(I_S5BRE)[((size_t)lg * 64 + pp) * 16 + h + 1], bi1 = FIN(I_S5BIM)[((size_t)lg * 64 + pp) * 16 + h + 1];
            *(unsigned*)(pt0 + h) = pk2(zfr * br0 - zfi * bi0, zfr * br1 - zfi * bi1);
            *(unsigned*)(pt0 + 1024 + h) = pk2(zfr * bi0 + zfi * br0, zfr * bi1 + zfi * br1); }
        const float e2 = (float)(s + 1), m2 = expf(e2 * are * step), yr = m2 * cosf(e2 * aim * step), yi = m2 * sinf(e2 * aim * step);
#pragma unroll
        for (int h = 0; h < 16; ++h) { const float cr = FIN(I_S5CRE)[((size_t)lg * 16 + h) * 64 + pp], ci = FIN(I_S5CIM)[((size_t)lg * 16 + h) * 64 + pp];
            *(unsigned*)(F_QT + ((size_t)lg * 1024 + s * 16 + h) * 128 + 2 * pp) = pk2(cr * yr - ci * yi, -(cr * yi + ci * yr)); }
    }
    for (int it = gw; it < DEPTH * 16 * 64; it += NGW) {
        const int d = it & 63, lg = it >> 6, pp = F.lane;
        { const float are = FIN(I_S5ARE)[lg * 64 + pp], aim = FIN(I_S5AIM)[lg * 64 + pp], step = expf(FIN(I_S5LS)[lg]);
          const float mag = expf(are * step), lr = mag * cosf(aim * step), li = mag * sinf(aim * step);
          const float den = are * are + aim * aim, nr = lr - 1.0f, fre = (nr * are + li * aim) / den, fim = (li * are - nr * aim) / den;
          const float e1 = (float)d, m1 = expf(e1 * are * step), zr = m1 * cosf(e1 * aim * step), zi = m1 * sinf(e1 * aim * step);
          scr[2 * pp] = zr * fre - zi * fim; scr[2 * pp + 1] = zr * fim + zi * fre; }
        LDS_WAIT(); asm volatile("" ::: "memory");
        const int h = F.lane >> 2, k0 = (F.lane & 3) * 4;
        float o[4] = {0.f, 0.f, 0.f, 0.f};
        for (int p2 = 0; p2 < 64; ++p2) {
            const float zr = scr[2 * p2], zi = scr[2 * p2 + 1];
            const float cr = FIN(I_S5CRE)[((size_t)lg * 16 + h) * 64 + p2], ci = FIN(I_S5CIM)[((size_t)lg * 16 + h) * 64 + p2];
            const f32x4 br = *(const f32x4*)(FIN(I_S5BRE) + ((size_t)lg * 64 + p2) * 16 + k0), bi = *(const f32x4*)(FIN(I_S5BIM) + ((size_t)lg * 64 + p2) * 16 + k0);
#pragma unroll
            for (int e = 0; e < 4; ++e) { const float tr = zr * br[e] - zi * bi[e], ti = zr * bi[e] + zi * br[e]; o[e] += cr * tr - ci * ti; }
        }
        *(unsigned long long*)(F_KT + ((size_t)lg * 64 + d) * 256 + h * 16 + k0) = (unsigned long long)pk2(o[0], o[1]) | ((unsigned long long)pk2(o[2], o[3]) << 32);
        LDS_WAIT(); asm volatile("" ::: "memory");
    }
    for (int i = gw * 64 + F.lane; i < DEPTH * D; i += NGW * 64) { const int l = i / D, k = i % D;
        *(f32x4*)(F_WDT + (size_t)i * 4) = *(const f32x4*)(FIN(I_WIN) + ((size_t)l * D + k) * NPROJ_SRC + 2048); }
    constexpr int I_IN = (D / 64) * (NPROJ / 32), I_O = (D / 64) * (D / 32), I_1 = (D / 64) * (FF / 32), I_2 = (FF / 64) * (D / 32), I_L = I_IN + I_O + I_1 + I_2;
    for (int it = gw; it < DEPTH * I_L; it += NGW) {
        const int l = it / I_L; int r = it % I_L;
        if (r < I_IN) { p0_transpose_item(FIN(I_WIN) + (size_t)l * D * NPROJ_SRC, D, NPROJ_SRC, NPROJ / 32, 2048, 4, F_WinT + (size_t)l * NPROJ * D, scr, r, F.lane); continue; } r -= I_IN;
        if (r < I_O) { p0_transpose_item(FIN(I_WOUT) + (size_t)l * D * D, D, D, D / 32, 1 << 30, 0, F_WoutT + (size_t)l * D * D, scr, r, F.lane); continue; } r -= I_O;
        if (r < I_1) { p0_transpose_item(FIN(I_W1) + (size_t)l * D * FF, D, FF, FF / 32, 1 << 30, 0, F_W1T + (size_t)l * FF * D, scr, r, F.lane); continue; } r -= I_1;
        p0_transpose_item(FIN(I_W2) + (size_t)l * FF * D, FF, D, D / 32, 1 << 30, 0, F_W2T + (size_t)l * D * FF, scr, r, F.lane);
    }
}

__device__ __forceinline__ void norm_phase(Frame& F, const float* src, const float* nw, int l, int sh_idx, int sc_idx, bf16* dst, bool do_dt) {
    const int gw = F.vcu * NWAVES + F.wave, NGW = F.G * NWAVES, lane = F.lane;
    for (int blk = gw; blk < M / 8; blk += NGW) {
        const int m0 = blk * 8, b = m0 / SEQ;
        f32x4 nwv[4], shv[4], scv[4];
#pragma unroll
        for (int j = 0; j < 4; ++j) { const int col = 4 * lane + 256 * j; nwv[j] = *(const f32x4*)(nw + col); shv[j] = modv4(F, l, b, sh_idx, col); scv[j] = modv4(F, l, b, sc_idx, col) + 1.0f;
            asm volatile("" : "+v"(shv[j]), "+v"(scv[j]) :: "memory"); }
        for (int i = 0; i < 8; ++i) {
            const int m = m0 + i;
            const f32x4* xr = (const f32x4*)(src + (size_t)m * D) + lane;
            f32x4 v[4]; float ss = 0.f;
#pragma unroll
            for (int j = 0; j < 4; ++j) { v[j] = xr[64 * j]; ss += (v[j].x * v[j].x + v[j].y * v[j].y) + (v[j].z * v[j].z + v[j].w * v[j].w); }
            const float r = 1.0f / sqrtf(wave_sum(ss) * (1.0f / D) + EPS);
            unsigned long long* o8 = (unsigned long long*)(dst + (size_t)m * D) + lane;
#pragma unroll
            for (int j = 0; j < 4; ++j) { v[j] = (v[j] * r) * nwv[j] * scv[j] + shv[j];
                o8[64 * j] = (unsigned long long)pk2(v[j].x, v[j].y) | ((unsigned long long)pk2(v[j].z, v[j].w) << 32); }
            if (do_dt) {
                const float* wdt = F_WDT + (size_t)l * D * 4 + 16 * lane;
                f32x4 d = {0.f, 0.f, 0.f, 0.f};
#pragma unroll
                for (int j = 0; j < 4; ++j)
#pragma unroll
                    for (int e = 0; e < 4; ++e) d += *(const f32x4*)(wdt + (256 * j + e) * 4) * v[j][e];
                d.x = wave_sum(d.x); d.y = wave_sum(d.y); d.z = wave_sum(d.z); d.w = wave_sum(d.w);
                if (lane == 0) *(f32x4*)(F_DT + (size_t)m * 4) = d;
            }
        }
    }
}

__device__ __forceinline__ void final_norm_phase(Frame& F) {
    const int gw = F.vcu * NWAVES + F.wave, NGW = F.G * NWAVES, lane = F.lane; const float* nw = FIN(I_FNW);
    f32x4 nwv[4];
#pragma unroll
    for (int j = 0; j < 4; ++j) nwv[j] = *(const f32x4*)(nw + 4 * lane + 256 * j);
    for (int m = gw; m < M; m += NGW) {
        f32x4* xr = (f32x4*)(F_H + (size_t)m * D) + lane;
        f32x4 v[4]; float ss = 0.f;
#pragma unroll
        for (int j = 0; j < 4; ++j) { v[j] = xr[64 * j]; ss += (v[j].x * v[j].x + v[j].y * v[j].y) + (v[j].z * v[j].z + v[j].w * v[j].w); }
        const float r = 1.0f / sqrtf(wave_sum(ss) * (1.0f / D) + EPS);
#pragma unroll
        for (int j = 0; j < 4; ++j) xr[64 * j] = (v[j] * r) * nwv[j];
    }
}

__device__ __forceinline__ void x1_pool_sconv(Frame& F, int l) {
    const int gw = F.vcu * NWAVES + F.wave, NGW = F.G * NWAVES, lane = F.lane;
    LAS float* ps = (LAS float*)(F.lds + RING_OFF + F.wave * 16384);
    const float* pw = FIN(I_POOLW) + (size_t)l * 4 * 64 * 64; const float* pscale = FIN(I_POOLS) + l * 256; const float* bnw = FIN(I_BNW) + l * D;
    const float* sw = FIN(I_SCONVW) + (size_t)l * 3 * 256;
    for (int blk = gw; blk < M / 8; blk += NGW) {
        const int m0 = blk * 8;
        {
            float s[8][4], v0[8][4];
#pragma unroll
            for (int tok = 0; tok < 8; ++tok)
#pragma unroll
                for (int g = 0; g < 4; ++g) { s[tok][g] = 0.f; v0[tok][g] = 0.f; }
            const int t0 = m0 & (SEQ - 1);
#pragma unroll 1
            for (int rr = -15; rr < 8; ++rr) {
                if (t0 + rr < 0) continue;
                const bf16* row = F_PROJ + (size_t)(m0 + rr) * NPP + PC_POOL + lane;
                float x[4];
#pragma unroll
                for (int g = 0; g < 4; ++g) x[g] = bf2f(row[g * 64]);
#pragma unroll
                for (int tok = 0; tok < 8; ++tok) { const int j = tok - rr;
#pragma unroll
                    for (int g = 0; g < 4; ++g) { const bool in = (j >= 0) && (j < (2 << g)); s[tok][g] += in ? x[g] : 0.f; v0[tok][g] = (j == 0) ? x[g] : v0[tok][g]; } }
            }
#pragma unroll
            for (int tok = 0; tok < 8; ++tok) { const int t = t0 + tok;
#pragma unroll
                for (int g = 0; g < 4; ++g) { const int win = 2 << g, cnt = (t + 1 < win) ? (t + 1) : win; ps[tok * 256 + g * 64 + lane] = s[tok][g] / (float)cnt - v0[tok][g]; } }
        }
        LDS_WAIT(); asm volatile("" ::: "memory");
        float acc[8][4];
#pragma unroll
        for (int tok = 0; tok < 8; ++tok)
#pragma unroll
            for (int g = 0; g < 4; ++g) acc[tok][g] = 0.f;
        for (int c = 0; c < 64; ++c) {
            float w[4];
#pragma unroll
            for (int g = 0; g < 4; ++g) w[g] = pw[(size_t)(g * 64 + c) * 64 + lane];
#pragma unroll
            for (int tok = 0; tok < 8; ++tok)
#pragma unroll
                for (int g = 0; g < 4; ++g) acc[tok][g] += ps[tok * 256 + g * 64 + c] * w[g];
        }
        LDS_WAIT(); asm volatile("" ::: "memory");
#pragma unroll
        for (int tok = 0; tok < 8; ++tok) {
            const int m = m0 + tok; float y[4], ss = 0.f;
#pragma unroll
            for (int g = 0; g < 4; ++g) { y[g] = acc[tok][g] * pscale[g * 64 + lane]; ss += y[g] * y[g]; }
            const float r = 1.0f / sqrtf(wave_sum(ss) * (1.0f / 256.f) + EPS);
#pragma unroll
            for (int g = 0; g < 4; ++g) F_GROUPS[(size_t)m * D + g * 64 + lane] = (bf16)f2bf(y[g] * r * bnw[g * 64 + lane]);
        }
        for (int tok = 0; tok < 8; ++tok) {
            const int m = m0 + tok, t = m & (SEQ - 1); float y[4], ss = 0.f;
#pragma unroll
            for (int j = 0; j < 4; ++j) {
                const int c = lane + 64 * j; const bf16* row = F_PROJ + (size_t)m * NPP;
                float a = 0.f;
#pragma unroll
                for (int k = 0; k < 3; ++k) { const int back = 2 - k; const bool ok = t >= back; const bf16* rr = row - (ok ? (size_t)back * NPP : 0);
                    const float gc = bf2f(rr[PC_GC + c]), hh = bf2f(rr[PC_H + c]); a += ok ? sw[k * 256 + c] * (gc * hh) : 0.f; }
                y[j] = bf2f(row[PC_GB + c]) * a; ss += y[j] * y[j];
            }
            const float r = 1.0f / sqrtf(wave_sum(ss) * (1.0f / 256.f) + EPS);
#pragma unroll
            for (int j = 0; j < 4; ++j) { const int c = lane + 64 * j; F_GROUPS[(size_t)m * D + 256 + c] = (bf16)f2bf(y[j] * r * bnw[256 + c]); }
        }
    }
}

typedef float f32x16 __attribute__((ext_vector_type(16)));
__device__ __forceinline__ void s5_send_item(Frame& F, int l, int j) {
    const int lane = F.lane, c = lane & 31, hh = lane >> 5;
    const int g = j >> 5, mt = (j >> 2) & 7, nt = j & 3;
    const bf16* A = F_US5 + ((size_t)g * M + (size_t)(mt * 32 + c) * 64) * 16 + 8 * hh;
    const bf16* Bt = F_PT + ((size_t)(l * 16 + g) * 128 + nt * 32 + c) * 1024 + 8 * hh;
    f32x16 acc;
#pragma unroll
    for (int r = 0; r < 16; ++r) acc[r] = 0.f;
#pragma unroll 8
    for (int s = 0; s < 64; ++s) acc = __builtin_amdgcn_mfma_f32_32x32x16_bf16(*(const bf16x8*)(A + s * 16), *(const bf16x8*)(Bt + s * 16), acc, 0, 0, 0);
#pragma unroll
    for (int r = 0; r < 16; ++r) { const int row = mt * 32 + (r & 3) + 8 * (r >> 2) + 4 * hh; F_SEND[((size_t)g * NCHR + row) * 128 + nt * 32 + c] = acc[r]; }
}
__device__ __forceinline__ void s5_xb_item(Frame& F, int l, int b, int g, int mt) {
    const int lane = F.lane, c = lane & 31, hh = lane >> 5, lg = l * 16 + g;
    LAS bf16* sp = (LAS bf16*)(F.lds);
    if (F.wave == 0) {
        const float are = FIN(I_S5ARE)[lg * 64 + lane], aim = FIN(I_S5AIM)[lg * 64 + lane], step = expf(FIN(I_S5LS)[lg]);
        const float m64 = expf(64.f * are * step), l64r = m64 * cosf(64.f * aim * step), l64i = m64 * sinf(64.f * aim * step);
        float cr = 0.f, ci = 0.f;
        const float* se = F_SEND + ((size_t)g * NCHR + b * 128) * 128 + 2 * lane;
        for (int c0 = 0; c0 < (mt + 1) * 32; c0 += 8) {
            float er[8], ei[8];
#pragma unroll
            for (int i = 0; i < 8; ++i) { const float* q = se + (size_t)(c0 + i) * 128; er[i] = q[0]; ei[i] = q[1]; }
#pragma unroll
            for (int i = 0; i < 8; ++i) { const int rl = c0 + i - mt * 32; if (rl >= 0) *(LAS unsigned*)(sp + rl * 136 + 2 * lane) = pk2(cr, ci);
                const float nr = l64r * cr - l64i * ci + er[i], ni = l64r * ci + l64i * cr + ei[i]; cr = nr; ci = ni; }
        }
    }
    __syncthreads();
    const float dsk = FIN(I_S5D)[l * 256 + g * 16 + (c & 15)];
    bf16x8 af[8];
#pragma unroll
    for (int k = 0; k < 8; ++k) af[k] = *(const LAS bf16x8*)(sp + c * 136 + k * 16 + 8 * hh);
    const int crow0 = b * 128 + mt * 32;
    const bf16* A = F_US5 + ((size_t)g * M + (size_t)(crow0 + c) * 64) * 16 + 8 * hh;
    const bf16* KTg = F_KT + (size_t)lg * 64 * 256 + (c & 15) * 16 + 8 * hh;
    const bf16x8 zero = {0, 0, 0, 0, 0, 0, 0, 0};
#pragma unroll 1
    for (int i = 0; i < 4; ++i) {
        const int q = F.wave, tb = (i == 0) ? q : (i == 1) ? 15 - q : (i == 2) ? 16 + q : 31 - q;
        const int t = 2 * tb + (c >> 4), h = c & 15;
        const bf16* Bt = F_QT + ((size_t)lg * 1024 + tb * 32 + c) * 128 + 8 * hh;
        f32x16 acc;
#pragma unroll
        for (int r = 0; r < 16; ++r) acc[r] = 0.f;
#pragma unroll
        for (int k = 0; k < 8; ++k) acc = __builtin_amdgcn_mfma_f32_32x32x16_bf16(af[k], *(const bf16x8*)(Bt + k * 16), acc, 0, 0, 0);
        const int ns = 2 * tb + 2;
#pragma unroll 4
        for (int s = 0; s < ns; ++s) {
            const int d = t - s; const bf16x8 bl = *(const bf16x8*)(KTg + (d < 0 ? 0 : d) * 256); const bf16x8 bq = (d >= 0) ? bl : zero;
            acc = __builtin_amdgcn_mfma_f32_32x32x16_bf16(*(const bf16x8*)(A + s * 16), bq, acc, 0, 0, 0);
        }
#pragma unroll
        for (int r = 0; r < 16; ++r) { const int row = crow0 + (r & 3) + 8 * (r >> 2) + 4 * hh; const size_t tok = (size_t)row * 64 + t;
            F_YS[tok * 256 + g * 16 + h] = acc[r] + dsk * bf2f(F_US5[((size_t)g * M + tok) * 16 + h]); }
    }
    __syncthreads();
}

constexpr int SPD = 136;
constexpr int SS_CM = 0, SS_BM = 128 * SPD * 2, SS_BT = 2 * 128 * SPD * 2, SS_XDT = 3 * 128 * SPD * 2, SS_XDE = SS_XDT + 64 * SPD * 2, SS_F32 = SS_XDE + 64 * SPD * 2;
static_assert(SS_F32 + 1024 <= LDSCTL_OFF, "SSD unit LDS map");
__device__ __forceinline__ void ssd_chunk_unit(Frame& F, int l, int b, int cc, int h) {
    const int lane = F.lane, wave = F.wave, g = h >> 1, c = lane & 31, hh = lane >> 5;
    const int m0 = b * SEQ + cc * 128;
    LAS bf16* Cm = (LAS bf16*)(F.lds + SS_CM); LAS bf16* Bm = (LAS bf16*)(F.lds + SS_BM); LAS bf16* BT = (LAS bf16*)(F.lds + SS_BT);
    LAS bf16* XdtT = (LAS bf16*)(F.lds + SS_XDT); LAS bf16* XdeT = (LAS bf16*)(F.lds + SS_XDE);
    LAS float* dts = (LAS float*)(F.lds + SS_F32); LAS float* acs = dts + 128;
    if (wave == 0) {
        const float dtb = FIN(I_DTB)[l * 4 + h], a = -__expf(FIN(I_ALOG)[l * 4 + h]);
        const float d0 = softplusf(F_DT[(size_t)(m0 + lane) * 4 + h] + dtb), d1 = softplusf(F_DT[(size_t)(m0 + 64 + lane) * 4 + h] + dtb);
        float v0 = a * d0, v1 = a * d1;
#pragma unroll
        for (int o = 1; o < 64; o <<= 1) { const float t0 = __shfl_up(v0, o), t1 = __shfl_up(v1, o); if (lane >= o) { v0 += t0; v1 += t1; } }
        v1 += __shfl(v0, 63);
        dts[lane] = d0; dts[64 + lane] = d1; acs[lane] = v0; acs[64 + lane] = v1;
        F_ACS[(size_t)(m0 + lane) * 4 + h] = v0; F_ACS[(size_t)(m0 + 64 + lane) * 4 + h] = v1;
    }
    __syncthreads();
    {
        const float aend = acs[127];
        const float* cw = FIN(I_SSDCW) + (size_t)l * 4 * 768; const float* cbias = FIN(I_SSDCB) + (size_t)l * 768;
        const int t_seq0 = cc * 128;
        for (int it = wave; it < 20; it += NWAVES) {
            const int cb = it >> 2, tq = it & 3;
            const int ch = (cb == 0) ? (h * 64 + lane) : (cb < 3) ? (256 + g * 128 + (cb - 1) * 64 + lane) : (512 + g * 128 + (cb - 3) * 64 + lane);
            const bf16* src = F_PROJ + (size_t)(m0 + tq * 32) * NPP + PC_X + ch;
            const float w0 = cw[ch], w1 = cw[768 + ch], w2 = cw[2 * 768 + ch], w3 = cw[3 * 768 + ch], bs = cbias[ch];
            float raw[35];
#pragma unroll
            for (int i = 0; i < 35; ++i) { const bool ok = (t_seq0 + tq * 32 + i - 3) >= 0; raw[i] = ok ? bf2f(src[(long)(i - 3) * NPP]) : 0.f; }
#pragma unroll
            for (int i = 0; i < 32; ++i) {
                const int tl = tq * 32 + i;
                const float v = siluf(w3 * raw[i + 3] + w2 * raw[i + 2] + w1 * raw[i + 1] + w0 * raw[i] + bs);
                if (cb == 0) { F_XS[(size_t)(m0 + tl) * 256 + h * 64 + lane] = (bf16)f2bf(v);
                    const float xd = v * dts[tl]; XdtT[lane * SPD + tl] = (bf16)f2bf(xd); XdeT[lane * SPD + tl] = (bf16)f2bf(xd * __expf(aend - acs[tl])); }
                else if (cb < 3) { const int n = (cb - 1) * 64 + lane; const bf16 q = (bf16)f2bf(v); Bm[tl * SPD + n] = q; BT[n * SPD + tl] = q; }
                else { const int n = (cb - 3) * 64 + lane; const bf16 q = (bf16)f2bf(v); Cm[tl * SPD + n] = q; if ((h & 1) == 0) F_CS[(size_t)(m0 + tl) * 256 + g * 128 + n] = q; }
            }
        }
    }
    __syncthreads();
    {
        const int j = wave & 3, pt = wave >> 2;
        bf16x8 cf[8];
#pragma unroll
        for (int ks = 0; ks < 8; ++ks) cf[ks] = *(const LAS bf16x8*)(Cm + (j * 32 + c) * SPD + ks * 16 + 8 * hh);
        const float al = acs[j * 32 + c];
        f32x16 yacc;
#pragma unroll
        for (int r = 0; r < 16; ++r) yacc[r] = 0.f;
        for (int i = 0; i <= j; ++i) {
            f32x16 X;
#pragma unroll
            for (int r = 0; r < 16; ++r) X[r] = 0.f;
#pragma unroll
            for (int ks = 0; ks < 8; ++ks) X = __builtin_amdgcn_mfma_f32_32x32x16_bf16(*(const LAS bf16x8*)(Bm + (i * 32 + c) * SPD + ks * 16 + 8 * hh), cf[ks], X, 0, 0, 0);
#pragma unroll
            for (int r = 0; r < 16; ++r) { const int s = i * 32 + (r & 3) + 8 * (r >> 2) + 4 * hh; const float e = __expf(al - acs[s]); X[r] = (s <= j * 32 + c) ? X[r] * e : 0.f; }
#pragma unroll
            for (int ks2 = 0; ks2 < 2; ++ks2) {
                bf16x8 xa; unsigned* xw = (unsigned*)&xa;
#pragma unroll
                for (int e = 0; e < 4; ++e) xw[e] = pk2(X[8 * ks2 + 2 * e], X[8 * ks2 + 2 * e + 1]);
                const LAS bf16* xq = XdtT + (pt * 32 + c) * SPD + i * 32 + 16 * ks2 + 4 * hh;
                const unsigned long long lo = *(const LAS unsigned long long*)xq, hi = *(const LAS unsigned long long*)(xq + 8);
                bf16x8 xb; unsigned long long* xbw = (unsigned long long*)&xb; xbw[0] = lo; xbw[1] = hi;
                yacc = __builtin_amdgcn_mfma_f32_32x32x16_bf16(xa, xb, yacc, 0, 0, 0);
            }
        }
#pragma unroll
        for (int r = 0; r < 16; ++r) { const int tl = j * 32 + (r & 3) + 8 * (r >> 2) + 4 * hh; F_YC[(size_t)(m0 + tl) * 256 + h * 64 + pt * 32 + c] = yacc[r]; }
        f32x16 st;
#pragma unroll
        for (int r = 0; r < 16; ++r) st[r] = 0.f;
#pragma unroll
        for (int ks = 0; ks < 8; ++ks) st = __builtin_amdgcn_mfma_f32_32x32x16_bf16(*(const LAS bf16x8*)(XdeT + (pt * 32 + c) * SPD + ks * 16 + 8 * hh), *(const LAS bf16x8*)(BT + (j * 32 + c) * SPD + ks * 16 + 8 * hh), st, 0, 0, 0);
        float* so = F_ST + ((size_t)((b * 64 + cc) * 4 + h) * 64) * 128;
#pragma unroll
        for (int r = 0; r < 16; ++r) { const int pp = pt * 32 + (r & 3) + 8 * (r >> 2) + 4 * hh; so[(size_t)pp * 128 + j * 32 + c] = st[r]; }
    }
    __syncthreads();
}
__device__ __forceinline__ void ssd_scan_item(Frame& F, int gws) {
    const int e = gws * 64 + F.lane, bh = e >> 13, pn = e & 8191, b = bh >> 2, h = bh & 3;
    const float* st = F_ST + ((size_t)(b * 64 * 4 + h) * 8192) + pn; bf16* pv = F_PREV + ((size_t)(b * 64 * 4 + h) * 8192) + pn;
    const float* ae = F_ACS + ((size_t)b * SEQ + 127) * 4 + h;
    float carry = 0.f;
    for (int c0 = 0; c0 < 64; c0 += 8) {
        float sv[8], dv[8];
#pragma unroll
        for (int i = 0; i < 8; ++i) { sv[i] = st[(size_t)(c0 + i) * 4 * 8192]; dv[i] = ae[(size_t)(c0 + i) * 128 * 4]; }
#pragma unroll
        for (int i = 0; i < 8; ++i) { pv[(size_t)(c0 + i) * 4 * 8192] = (bf16)f2bf(carry); carry = carry * __expf(dv[i]) + sv[i]; }
    }
}
__device__ __forceinline__ void ssd_yoff_item(Frame& F, int l, int it) {
    const int lane = F.lane, c = lane & 31, hh = lane >> 5;
    const int lb = it & 3, h = (it >> 2) & 3, cc = (it >> 4) & 63, b = it >> 10, g = h >> 1;
    const int m0 = b * SEQ + cc * 128 + lb * 32;
    const bf16* A = F_CS + (size_t)(m0 + c) * 256 + g * 128 + 8 * hh;
    const bf16* Bt = F_PREV + ((size_t)((b * 64 + cc) * 4 + h) * 8192) + (size_t)c * 128 + 8 * hh;
    f32x16 a0, a1;
#pragma unroll
    for (int r = 0; r < 16; ++r) { a0[r] = 0.f; a1[r] = 0.f; }
#pragma unroll
    for (int ks = 0; ks < 8; ++ks) { const bf16x8 af = *(const bf16x8*)(A + ks * 16);
        a0 = __builtin_amdgcn_mfma_f32_32x32x16_bf16(af, *(const bf16x8*)(Bt + ks * 16), a0, 0, 0, 0);
        a1 = __builtin_amdgcn_mfma_f32_32x32x16_bf16(af, *(const bf16x8*)(Bt + 32 * 128 + ks * 16), a1, 0, 0, 0); }
    const float Dk = FIN(I_SSDD)[l * 4 + h];
#pragma unroll
    for (int r = 0; r < 16; ++r) { const size_t m = (size_t)(m0 + (r & 3) + 8 * (r >> 2) + 4 * hh); const float ea = __expf(F_ACS[m * 4 + h]);
#pragma unroll
        for (int pt = 0; pt < 2; ++pt) { const int ch = h * 64 + pt * 32 + c; const float acc = pt ? a1[r] : a0[r];
            const float y = (F_YC[m * 256 + ch] + acc * ea + Dk * bf2f(F_XS[m * 256 + ch])) * siluf(bf2f(F_PROJ[m * NPP + PC_Z + ch]));
            F_YC[m * 256 + ch] = y; } }
}

__device__ __forceinline__ void x3_post(Frame& F, int l) {
    const int gw = F.vcu * NWAVES + F.wave, NGW = F.G * NWAVES, lane = F.lane;
    LAS float* gs = (LAS float*)(F.lds + RING_OFF + F.wave * 16384);
    const float* bnw = FIN(I_BNW) + l * D; const float* gwt = FIN(I_GLUW) + (size_t)l * 256 * 256; const float* gbias = FIN(I_GLUB) + l * 256;
    for (int blk = gw; blk < M / 8; blk += NGW) {
        const int m0 = blk * 8;
        for (int tok = 0; tok < 8; ++tok) {
            const int m = m0 + tok; float y[4], ss = 0.f;
#pragma unroll
            for (int j = 0; j < 4; ++j) { y[j] = F_YC[(size_t)m * 256 + lane + 64 * j]; ss += y[j] * y[j]; }
            const float r = 1.0f / sqrtf(wave_sum(ss) * (1.0f / 256.f) + EPS);
#pragma unroll
            for (int j = 0; j < 4; ++j) { const int c = lane + 64 * j; F_GROUPS[(size_t)m * D + 512 + c] = (bf16)f2bf(y[j] * r * bnw[512 + c]); }
#pragma unroll
            for (int j = 0; j < 4; ++j) gs[tok * 256 + lane + 64 * j] = gelu_tanh(F_YS[(size_t)m * 256 + lane + 64 * j]);
        }
        LDS_WAIT(); asm volatile("" ::: "memory");
        float acc[8][4];
#pragma unroll
        for (int tok = 0; tok < 8; ++tok)
#pragma unroll
            for (int j = 0; j < 4; ++j) acc[tok][j] = 0.f;
        for (int c = 0; c < 256; ++c) {
            float w[4];
#pragma unroll
            for (int j = 0; j < 4; ++j) w[j] = gwt[(size_t)c * 256 + lane + 64 * j];
#pragma unroll
            for (int tok = 0; tok < 8; ++tok) { const float gv = gs[tok * 256 + c];
#pragma unroll
                for (int j = 0; j < 4; ++j) acc[tok][j] += gv * w[j]; }
        }
#pragma unroll
        for (int tok = 0; tok < 8; ++tok) {
            const int m = m0 + tok; float y[4], ss = 0.f;
#pragma unroll
            for (int j = 0; j < 4; ++j) { const float gv = gs[tok * 256 + lane + 64 * j]; y[j] = gv * sigmf(acc[tok][j] + gbias[lane + 64 * j]); ss += y[j] * y[j]; }
            const float r = 1.0f / sqrtf(wave_sum(ss) * (1.0f / 256.f) + EPS);
#pragma unroll
            for (int j = 0; j < 4; ++j) { const int c = lane + 64 * j; F_GROUPS[(size_t)m * D + 768 + c] = (bf16)f2bf(y[j] * r * bnw[768 + c]); }
        }
        LDS_WAIT(); asm volatile("" ::: "memory");
    }
}

template <int l> __device__ __forceinline__ void layer_body(Frame& F, const XcdBarrier& bar) {
#define GRID_BAR() xcd_barrier(bar)
        const float* hsrc = (l == 0) ? FIN(I_X) : F_H;
    norm_phase(F, hsrc, FIN(I_NMIX) + l * D, l, 0, 1, F_UV, true);
    GRID_BAR();
    { pg8::Gemm g{F_UV, F_WinT + (size_t)l * NPROJ * D, M, 2048, D}; pg8::StaticOrder S; S.init(M, 2048, F.G, (int)blockIdx.x);
      pg8::EpiBf16<0> E{F_PROJ, NPP};
      pg8::gemm_phase<pg8::EpiBf16<0>, pg8::StaticOrder, true, true>(F.lds + RING_OFF, g, S, E); }
    { pg8::Gemm g{F_UV, F_WinT + (size_t)l * NPROJ * D + (size_t)2048 * D, M, 256, D}; pg8::StaticOrder S; S.init(M, 256, F.G, (int)blockIdx.x);
      pg8::EpiCompact16 E{F_US5, M};
      pg8::gemm_phase<pg8::EpiCompact16, pg8::StaticOrder, true, true>(F.lds + RING_OFF, g, S, E); }
    GRID_BAR();
    for (int u = F.vcu; u < 512; u += F.G) ssd_chunk_unit(F, l, u >> 8, (u >> 2) & 63, u & 3);
    for (int it = F.vcu * NWAVES + F.wave; it < 512; it += F.G * NWAVES) s5_send_item(F, l, it);
    x1_pool_sconv(F, l);
    GRID_BAR();
    if (F.vcu < 128) s5_xb_item(F, l, F.vcu >> 6, (F.vcu >> 2) & 15, F.vcu & 3);
    else { const int gws = (F.vcu - 128) * NWAVES + F.wave; if (gws < 1024) ssd_scan_item(F, gws); }
    GRID_BAR();
    for (int it = F.vcu * NWAVES + F.wave; it < 2048; it += F.G * NWAVES) ssd_yoff_item(F, l, it);
    GRID_BAR();
    x3_post(F, l);
    GRID_BAR();
    { pg8::Gemm g{F_GROUPS, F_WoutT + (size_t)l * D * D, M, D, D}; pg8::StaticOrder S; S.init(M, D, F.G, (int)blockIdx.x);
      pg8::EpiResGate E{hsrc, F_H, D, F_MODP + (size_t)l * 2 * MOD + 2 * D, FIN(I_ADAB) + (size_t)l * MOD + 2 * D, 2 * 2 * MOD, MOD, SEQ};
      pg8::gemm_phase<pg8::EpiResGate, pg8::StaticOrder, true, true>(F.lds + RING_OFF, g, S, E); }
    GRID_BAR();
    norm_phase(F, F_H, FIN(I_NMLP) + l * D, l, 3, 4, F_UV, false);
    GRID_BAR();
    { pg8::Gemm g{F_UV, F_W1T + (size_t)l * FF * D, M, FF, D}; pg8::StaticOrder S; S.init(M, FF, F.G, (int)blockIdx.x);
      pg8::EpiBf16<2> E{F_HID, FF};
      pg8::gemm_phase<pg8::EpiBf16<2>, pg8::StaticOrder, true, true>(F.lds + RING_OFF, g, S, E); }
    GRID_BAR();
    { pg8::Gemm g{F_HID, F_W2T + (size_t)l * D * FF, M, D, FF}; pg8::StaticOrder S; S.init(M, D, F.G, (int)blockIdx.x);
      pg8::EpiResGate E{F_H, F_H, D, F_MODP + (size_t)l * 2 * MOD + 5 * D, FIN(I_ADAB) + (size_t)l * MOD + 5 * D, 2 * 2 * MOD, MOD, SEQ};
      pg8::gemm_phase<pg8::EpiResGate, pg8::StaticOrder, true, true>(F.lds + RING_OFF, g, S, E); }
    GRID_BAR();
}

struct Args { const float* in[N_IN]; float* out; unsigned char* ws; };
__global__ void __launch_bounds__(NWAVES * 64, 2) mk_fwd(Args args_unused) {
    extern __shared__ __attribute__((aligned(16))) unsigned char lds[];
    Frame F;
    F.lds = (LAS unsigned char*)lds;
    F.MISC = (volatile LAS unsigned*)(F.lds + MISC_OFF);
    F.tid = threadIdx.x; F.lane = F.tid & 63; F.wave = __builtin_amdgcn_readfirstlane(F.tid >> 6);
    F.G = gridDim.x; { const int bx = blockIdx.x; F.vcu = (F.G % 8 == 0) ? (bx % 8) * (F.G / 8) + bx / 8 : bx; }
    F.karg = (const __attribute__((address_space(4))) unsigned char*)__builtin_amdgcn_kernarg_segment_ptr();
    F.ws = *(unsigned char* const __attribute__((address_space(4)))*)(F.karg + 8 * (N_IN + 1));
    F.ctl = (gu32*)(F.ws + WS_CTL);
    for (int u = F.tid; u < (LDS_BYTES - LDSCTL_OFF) / 4; u += NWAVES * 64) ((LAS unsigned*)(F.lds + LDSCTL_OFF))[u] = 0u;
    __syncthreads();
    XcdBarrier bar = xcd_barrier_post((unsigned*)(F.ctl + CW_BAR), F.MISC + 8);

    p0_prologue(F);
    GRID_BAR();
    layer_body<0>(F, bar);
    layer_body<1>(F, bar);
    final_norm_phase(F);
}

extern "C" void kernel_launch(void* const* d_in, const int* in_sizes, int n_in, void* d_out, int out_size, void* d_ws, size_t ws_size, hipStream_t stream) {
    static int grid = 0;
    if (grid == 0) {
        if (n_in != N_IN || in_sizes[0] != M * D || out_size != M * D || ws_size < WS_END) { fprintf(stderr, "kernel_launch: unexpected shapes (n_in %d, in0 %d, out %d, ws %zu); nothing launched\n", n_in, n_in > 0 ? in_sizes[0] : -1, out_size, ws_size); grid = -1; return; }
        int dev = 0, cus = 0, per_cu = 0;
        if (hipGetDevice(&dev) != hipSuccess || hipDeviceGetAttribute(&cus, hipDeviceAttributeMultiprocessorCount, dev) != hipSuccess) { grid = -1; return; }
        if (hipFuncSetAttribute((const void*)mk_fwd, hipFuncAttributeMaxDynamicSharedMemorySize, LDS_BYTES) != hipSuccess) { fprintf(stderr, "kernel_launch: hipFuncSetAttribute failed\n"); grid = -1; return; }
        if (hipOccupancyMaxActiveBlocksPerMultiprocessor(&per_cu, (const void*)mk_fwd, NWAVES * 64, LDS_BYTES) != hipSuccess || per_cu < 1) fprintf(stderr, "kernel_launch: occupancy query reports %d\n", per_cu);
        (void)hipGetLastError();
        grid = cus;
    }
    if (grid < 0) return;
    if (hipMemsetAsync((char*)d_ws + WS_CTL, 0, CTL_ZERO_BYTES, stream) != hipSuccess) return;
    Args a{};
    for (int i = 0; i < N_IN; ++i) a.in[i] = (const float*)d_in[i];
    a.out = (float*)d_out; a.ws = (unsigned char*)d_ws;
    hipLaunchKernelGGL(mk_fwd, dim3(grid), dim3(NWAVES * 64), LDS_BYTES, stream, a);
}
```

```cpp
#include <hip/hip_runtime.h>
#include <cstdio>
#include <cstdint>
#include <cmath>
namespace pg8 {
#define PG8_LAS __attribute__((address_space(3)))
typedef unsigned short bf16_t;
typedef short bf16x8 __attribute__((ext_vector_type(8)));
typedef float f32x4 __attribute__((ext_vector_type(4)));
typedef unsigned u32x4 __attribute__((ext_vector_type(4)));
constexpr int BM = 256, BK = 64, HALF = 128, HTB = HALF * BK * 2  , STAGE_BYTES = 8 * HTB, NXCD = 8, WGM = 8;

__host__ __device__ __forceinline__ int lds_byte(int r, int c) { const int st = (r >> 4) * 2 + (c >> 5), rr = r & 15, cc = c & 31, ob = rr * 64 + cc * 2; return st * 1024 + (ob ^ (((ob >> 9) & 1) << 5)); }
__host__ __device__ __forceinline__ void stage_rc(int b, int& R, int& C) { const int st = b / 1024, sb = b % 1024, swz = sb ^ (((sb >> 9) & 1) << 5); R = (st >> 1) * 16 + swz / 64; C = (st & 1) * 32 + (swz % 64) / 2; }
__host__ __device__ __forceinline__ int perm32(int rho) { const int n = rho >> 4, i = rho & 15; return 8 * (i >> 2) + 4 * n + (i & 3); }

struct Unit { int pm, pn; };
struct Gemm { const bf16_t* A; const bf16_t* Bt; int M, N, K; };

struct StaticOrder {
    int nM, nN, nwg, G, c;
    __host__ __device__ void init(int M, int N, int G_, int c_) { nM = M / BM; nN = N / BM; nwg = nM * nN; G = G_; c = c_; }
    __host__ __device__ bool next(int i, Unit& u) const {
        const long L = (long)i * G + c; if (L >= nwg) return false;
        int wgid = (int)L; { const int q = nwg / NXCD, r = nwg % NXCD, xcd = wgid % NXCD, off = wgid / NXCD; wgid = (xcd < r ? xcd * (q + 1) : r * (q + 1) + (xcd - r) * q) + off; }
        const int nig = WGM * nN, gid = wgid / nig, fm = gid * WGM, gsz = (nM - fm) < WGM ? (nM - fm) : WGM;
        u.pm = fm + ((wgid % nig) % gsz); u.pn = (wgid % nig) / gsz; return true;
    }
    __device__ __forceinline__ void a_ready(const Unit&) const {}
    __device__ __forceinline__ void done(const Unit&) const {}
};


__device__ __forceinline__ unsigned cvt_pk_bf16(float lo, float hi) { unsigned r; asm volatile("v_cvt_pk_bf16_f32 %0, %1, %2" : "=v"(r) : "v"(lo), "v"(hi)); return r; }

template <int ACT> struct EpiBf16 {
    static constexpr bool PERM = true, AFTER_DRAIN = false;
    bf16_t* O; int ldc;
    __device__ __forceinline__ void operator()(const f32x4 (&acc)[2][2][4][2], const Unit& u, int wr, int wc, int fr, int fq) const {
        const int row0 = u.pm * BM + wr * 64 + fr; const int col0 = u.pn * BM + wc * 32 + 8 * fq;
#pragma unroll
        for (int ai = 0; ai < 2; ++ai)
#pragma unroll
            for (int m = 0; m < 4; ++m) { bf16_t* rowp = O + (size_t)(row0 + ai * HALF + m * 16) * ldc + col0;
#pragma unroll
                for (int bj = 0; bj < 2; ++bj) { f32x4 v0 = acc[ai][bj][m][0], v1 = acc[ai][bj][m][1];
                    if (ACT == 2) {
#pragma unroll
                        for (int e = 0; e < 4; ++e) { const float a = v0[e] > 0.f ? v0[e] : 0.f, b = v1[e] > 0.f ? v1[e] : 0.f; v0[e] = a * a; v1[e] = b * b; } }
                    u32x4 w; w.x = cvt_pk_bf16(v0[0], v0[1]); w.y = cvt_pk_bf16(v0[2], v0[3]); w.z = cvt_pk_bf16(v1[0], v1[1]); w.w = cvt_pk_bf16(v1[2], v1[3]);
                    *(u32x4*)(rowp + bj * HALF) = w; } }
    }
};
struct EpiCompact16 {
    static constexpr bool PERM = true, AFTER_DRAIN = false;
    bf16_t* O; int M2;
    __device__ __forceinline__ void operator()(const f32x4 (&acc)[2][2][4][2], const Unit& u, int wr, int wc, int fr, int fq) const {
        const int row0 = u.pm * BM + wr * 64 + fr; const int cl = wc * 32 + 8 * fq;
        bf16_t* const base = O + (size_t)(cl >> 4) * M2 * 16 + (cl & 15);
#pragma unroll
        for (int ai = 0; ai < 2; ++ai)
#pragma unroll
            for (int m = 0; m < 4; ++m) { bf16_t* rowp = base + (size_t)(row0 + ai * HALF + m * 16) * 16;
#pragma unroll
                for (int bj = 0; bj < 2; ++bj) { const f32x4 v0 = acc[ai][bj][m][0], v1 = acc[ai][bj][m][1];
                    u32x4 w; w.x = cvt_pk_bf16(v0[0], v0[1]); w.y = cvt_pk_bf16(v0[2], v0[3]); w.z = cvt_pk_bf16(v1[0], v1[1]); w.w = cvt_pk_bf16(v1[2], v1[3]);
                    *(u32x4*)(rowp + (size_t)bj * 8 * M2 * 16) = w; } }
    }
};

struct EpiResGate {
    static constexpr bool PERM = false, AFTER_DRAIN = false;
    const float* base; float* out; int ldc; const float* gp; const float* gb; int gps, gbs, rows_per_batch;
    __device__ __forceinline__ void operator()(const f32x4 (&acc)[2][2][4][2], const Unit& u, int wr, int wc, int fr, int fq) const {
        const int col0 = u.pn * BM + wc * 32 + 4 * fq; const int b = (u.pm * BM) / rows_per_batch;
        f32x4 gv[2][2];
#pragma unroll
        for (int bj = 0; bj < 2; ++bj)
#pragma unroll
            for (int n = 0; n < 2; ++n) { const int c = col0 + bj * HALF + n * 16; const float* q = gp + (size_t)b * gbs + c;
                gv[bj][n] = *(const f32x4*)(gb + c) + ((*(const f32x4*)(q) + *(const f32x4*)(q + gps)) + (*(const f32x4*)(q + 2 * (size_t)gps) + *(const f32x4*)(q + 3 * (size_t)gps))); }
#pragma unroll
        for (int ai = 0; ai < 2; ++ai)
#pragma unroll
            for (int m = 0; m < 4; ++m) { const size_t off = (size_t)(u.pm * BM + ai * HALF + wr * 64 + m * 16 + fr) * ldc + col0;
#pragma unroll
                for (int bj = 0; bj < 2; ++bj)
#pragma unroll
                    for (int n = 0; n < 2; ++n) { const f32x4 bs = *(const f32x4*)(base + off + bj * HALF + n * 16);
                        *(f32x4*)(out + off + bj * HALF + n * 16) = bs + gv[bj][n] * acc[ai][bj][m][n]; }
                if (m & 1) asm volatile("" ::: "memory"); }
    }
};

template <class Epi, class Sched, bool ALIGN_EPI = false, bool SP2 = false>
__device__ __forceinline__ void gemm_phase(PG8_LAS unsigned char* lds, const Gemm g, const Sched& S, const Epi& E) {
    const int tid = threadIdx.x, wid = __builtin_amdgcn_readfirstlane(tid >> 6), lane = tid & 63, wr = wid >> 2, wc = wid & 3, fr = lane & 15, fq = lane >> 4;
    const int K = g.K, nt = K / BK;
    unsigned voffA[2], voffB[2];
#pragma unroll
    for (int i = 0; i < 2; ++i) { int R, C; stage_rc(tid * 16 + i * 8192, R, C); const int Rb = Epi::PERM ? ((R & ~31) + perm32(R & 31)) : R;
        voffA[i] = (unsigned)(R * K + C) * 2u; voffB[i] = (unsigned)(Rb * K + C) * 2u; }
    const size_t kstep = (size_t)(BK * 2);
    const size_t hstep = (size_t)HALF * K * 2;
    const size_t tstep = 2 * hstep;
    const unsigned ldsw = (unsigned)wid * 1024u;
    const int aoff = lds_byte(wr * 64 + fr, fq * 8), boff = lds_byte(wc * 32 + fr, fq * 8);
#define PG8_SA(b, h) (((b) * 2 + (h)) * HTB)
#define PG8_SB(b, h) ((4 + (b) * 2 + (h)) * HTB)
#define PG8_STAGE(bufoff, gbase, voff) do { _Pragma("unroll") for (int _i = 0; _i < 2; ++_i) \
        __builtin_amdgcn_global_load_lds((const unsigned*)((const char*)(gbase) + (voff)[_i]), (PG8_LAS unsigned*)(lds + (bufoff) + ldsw + _i * 8192), 16, 0, 0); } while (0)
#define PG8_LDA(dst, b, h) do { _Pragma("unroll") for (int m = 0; m < 4; ++m) _Pragma("unroll") for (int k = 0; k < 2; ++k) dst[m][k] = *(const PG8_LAS bf16x8*)(lds + PG8_SA(b, h) + aoff + m * 2048 + k * 1024); } while (0)
#define PG8_LDB(dst, b, h) do { _Pragma("unroll") for (int n = 0; n < 2; ++n) _Pragma("unroll") for (int k = 0; k < 2; ++k) dst[n][k] = *(const PG8_LAS bf16x8*)(lds + PG8_SB(b, h) + boff + n * 2048 + k * 1024); } while (0)
#define PG8_MMA(ai, bj, At, Bt) do { __builtin_amdgcn_s_setprio(1); _Pragma("unroll") for (int m = 0; m < 4; ++m) _Pragma("unroll") for (int n = 0; n < 2; ++n) _Pragma("unroll") for (int k = 0; k < 2; ++k) \
        acc[ai][bj][m][n] = __builtin_amdgcn_mfma_f32_16x16x32_bf16(Bt[n][k], At[m][k], acc[ai][bj][m][n], 0, 0, 0); __builtin_amdgcn_s_setprio(0); } while (0)
#define PG8_WAIT_V(n) asm volatile("s_waitcnt vmcnt(" #n ")" ::: "memory")
#define PG8_WAIT_L(n) asm volatile("s_waitcnt lgkmcnt(" #n ")" ::: "memory")
#define PG8_BAR __builtin_amdgcn_s_barrier()
#define PG8_SCHED __builtin_amdgcn_sched_barrier(0)
    Unit cur, nxt; int ui = 0;
    if (!S.next(0, cur)) return;
    f32x4 acc[2][2][4][2];
#pragma unroll
    for (int a = 0; a < 2; ++a)
#pragma unroll
        for (int b = 0; b < 2; ++b)
#pragma unroll
            for (int m = 0; m < 4; ++m)
#pragma unroll
                for (int n = 0; n < 2; ++n) acc[a][b][m][n] = (f32x4){0.f, 0.f, 0.f, 0.f};
    bf16x8 At[4][2], B0[2][2], B1[2][2];
    const char* cA = (const char*)g.A + (size_t)cur.pm * tstep; const char* cB = (const char*)g.Bt + (size_t)cur.pn * tstep;
    S.a_ready(cur);
    if constexpr (SP2) {
        PG8_STAGE(PG8_SB(0, 0), cB, voffB); PG8_STAGE(PG8_SB(0, 1), cB + hstep, voffB); PG8_STAGE(PG8_SA(0, 0), cA, voffA); PG8_STAGE(PG8_SA(0, 1), cA + hstep, voffA);
        if (wr == 1) PG8_BAR;
        PG8_WAIT_V(2); PG8_BAR;
        PG8_STAGE(PG8_SB(1, 0), cB + kstep, voffB); PG8_STAGE(PG8_SA(1, 0), cA + kstep, voffA); PG8_STAGE(PG8_SB(1, 1), cB + hstep + kstep, voffB);
        PG8_WAIT_V(6); PG8_BAR;
    } else {
        PG8_STAGE(PG8_SB(0, 0), cB, voffB); PG8_STAGE(PG8_SA(0, 0), cA, voffA); PG8_STAGE(PG8_SB(0, 1), cB + hstep, voffB); PG8_STAGE(PG8_SA(0, 1), cA + hstep, voffA);
        if (wr == 1) PG8_BAR;
        PG8_WAIT_V(4); PG8_BAR;
        PG8_STAGE(PG8_SB(1, 0), cB + kstep, voffB); PG8_STAGE(PG8_SA(1, 0), cA + kstep, voffA); PG8_STAGE(PG8_SB(1, 1), cB + hstep + kstep, voffB);
        PG8_WAIT_V(6); PG8_BAR;
    }
    for (;;) {
        const bool has_next = S.next(ui + 1, nxt);
        const char* nA = has_next ? (const char*)g.A + (size_t)nxt.pm * tstep : cA; const char* nB = has_next ? (const char*)g.Bt + (size_t)nxt.pn * tstep : cB;
        for (int t = 0; t < nt; t += 2) {
            const bool last = (t == nt - 2);
            const char* a1 = cA + (size_t)(t + 1) * kstep;
            const char* a2 = last ? nA : cA + (size_t)(t + 2) * kstep; const char* b2 = last ? nB : cB + (size_t)(t + 2) * kstep;
            const char* a3 = a2 + kstep; const char* b3 = b2 + kstep;
            if (last && has_next) S.a_ready(nxt);
            if constexpr (SP2) {
            PG8_LDB(B0, 0, 0); PG8_LDB(B1, 0, 1); PG8_SCHED; PG8_LDA(At, 0, 0); PG8_STAGE(PG8_SA(1, 1), a1 + hstep, voffA);
            PG8_WAIT_V(8); PG8_WAIT_L(0); PG8_BAR; PG8_MMA(0, 0, At, B0); PG8_MMA(0, 1, At, B1); PG8_BAR; PG8_SCHED;
            PG8_LDA(At, 0, 1); PG8_STAGE(PG8_SB(0, 0), b2, voffB); PG8_STAGE(PG8_SB(0, 1), b2 + hstep, voffB); PG8_STAGE(PG8_SA(0, 0), a2, voffA);
            PG8_WAIT_V(8); PG8_WAIT_L(0); PG8_BAR; PG8_MMA(1, 0, At, B0); PG8_MMA(1, 1, At, B1); PG8_BAR; PG8_SCHED;
            PG8_LDB(B0, 1, 0); PG8_LDB(B1, 1, 1); PG8_SCHED; PG8_LDA(At, 1, 0); PG8_STAGE(PG8_SA(0, 1), a2 + hstep, voffA);
            PG8_WAIT_V(8); PG8_WAIT_L(0); PG8_BAR; PG8_MMA(0, 0, At, B0); PG8_MMA(0, 1, At, B1); PG8_BAR; PG8_SCHED;
            PG8_LDA(At, 1, 1); PG8_STAGE(PG8_SB(1, 0), b3, voffB); PG8_STAGE(PG8_SB(1, 1), b3 + hstep, voffB); PG8_STAGE(PG8_SA(1, 0), a3, voffA);
            PG8_WAIT_V(8); PG8_WAIT_L(0); PG8_BAR; PG8_MMA(1, 0, At, B0); PG8_MMA(1, 1, At, B1); PG8_BAR; PG8_SCHED;
            } else {
            PG8_LDB(B0, 0, 0); PG8_SCHED; PG8_LDA(At, 0, 0); PG8_STAGE(PG8_SA(1, 1), a1 + hstep, voffA);
            PG8_WAIT_L(8); PG8_BAR; PG8_WAIT_L(0); PG8_MMA(0, 0, At, B0); PG8_BAR; PG8_SCHED;
            PG8_LDB(B1, 0, 1); PG8_STAGE(PG8_SB(0, 0), b2, voffB);
            PG8_BAR; PG8_WAIT_L(0); PG8_MMA(0, 1, At, B1); PG8_BAR;
            PG8_LDA(At, 0, 1); PG8_STAGE(PG8_SA(0, 0), a2, voffA);
            PG8_BAR; PG8_WAIT_L(0); PG8_MMA(1, 0, At, B0); PG8_BAR; PG8_SCHED;
            PG8_STAGE(PG8_SB(0, 1), b2 + hstep, voffB);
            PG8_WAIT_V(6); PG8_BAR; PG8_MMA(1, 1, At, B1); PG8_BAR;
            PG8_LDB(B0, 1, 0); PG8_SCHED; PG8_LDA(At, 1, 0); PG8_STAGE(PG8_SA(0, 1), a2 + hstep, voffA);
            PG8_WAIT_L(8); PG8_BAR; PG8_WAIT_L(0); PG8_MMA(0, 0, At, B0); PG8_BAR; PG8_SCHED;
            PG8_LDB(B1, 1, 1); PG8_STAGE(PG8_SB(1, 0), b3, voffB);
            PG8_BAR; PG8_WAIT_L(0); PG8_MMA(0, 1, At, B1); PG8_BAR;
            PG8_LDA(At, 1, 1); PG8_STAGE(PG8_SA(1, 0), a3, voffA);
            PG8_BAR; PG8_WAIT_L(0); PG8_MMA(1, 0, At, B0); PG8_BAR; PG8_SCHED;
            PG8_STAGE(PG8_SB(1, 1), b3 + hstep, voffB);
            PG8_WAIT_V(6); PG8_BAR; PG8_MMA(1, 1, At, B1); PG8_BAR;
            }
        }
        if constexpr (ALIGN_EPI) { if (wr == 0) PG8_BAR; }
        if constexpr (!Epi::AFTER_DRAIN) { E(acc, cur, wr, wc, fr, fq); S.done(cur); }
        if (!has_next) break;
#pragma unroll
        for (int a = 0; a < 2; ++a)
#pragma unroll
            for (int b = 0; b < 2; ++b)
#pragma unroll
                for (int m = 0; m < 4; ++m)
#pragma unroll
                    for (int n = 0; n < 2; ++n) acc[a][b][m][n] = (f32x4){0.f, 0.f, 0.f, 0.f};
        cur = nxt; cA = nA; cB = nB; ++ui;
        if constexpr (ALIGN_EPI) { if (wr == 1) PG8_BAR; }
    }
    PG8_WAIT_V(0);
    if constexpr (!ALIGN_EPI) { if (wr == 0) PG8_BAR; }
    PG8_BAR;
    if constexpr (Epi::AFTER_DRAIN) { E.fused(acc, cur, wr, wc, fr, fq, lds, wid, lane); S.done(cur); }
#undef PG8_SA
#undef PG8_SB
#undef PG8_STAGE
#undef PG8_LDA
#undef PG8_LDB
#undef PG8_MMA
#undef PG8_WAIT_V
#undef PG8_WAIT_L
#undef PG8_BAR
#undef PG8_SCHED
}
}

constexpr int NWAVES = 8;
constexpr int S5L = 64, NCHR = 256  ;
constexpr int BATCH = 2, SEQ = 8192, D = 1024, M = BATCH * SEQ, DEPTH = 2;
constexpr int NPROJ_SRC = 2308, NPROJ = 2304, NPP = 2048  , FF = 4096, MOD = 6 * D;
constexpr float EPS = 1e-6f;
constexpr int PC_POOL = 0, PC_GB = 256, PC_GC = 512, PC_H = 768, PC_Z = 1024, PC_X = 1280, PC_B = 1536, PC_C = 1792, PC_S5 = 2048;
enum { I_X = 0, I_C, I_NMIX, I_NMLP, I_ADAW, I_ADAB, I_WIN, I_POOLW, I_POOLS, I_SCONVW, I_SSDCW, I_SSDCB, I_DTB, I_ALOG, I_SSDD, I_S5ARE, I_S5AIM, I_S5LS, I_S5BRE, I_S5BIM,
       I_S5CRE, I_S5CIM, I_S5D, I_GLUW, I_GLUB, I_BNW, I_WOUT, I_W1, I_W2, I_FNW, N_IN };

constexpr size_t MiB = 1u << 20;
constexpr size_t WS_CTL = 0, CTL_ZERO_BYTES = 1 * MiB;
constexpr size_t WS_WIN = 1 * MiB;
constexpr size_t WS_WOUT = 10 * MiB;
constexpr size_t WS_W1 = 14 * MiB;
constexpr size_t WS_W2 = 30 * MiB;
constexpr size_t WS_UV = 46 * MiB;
constexpr size_t WS_ST = WS_UV;
constexpr size_t WS_PREV = WS_UV + 16 * MiB;
constexpr size_t WS_SEND = WS_UV + 24 * MiB;
constexpr size_t WS_ACS = WS_UV + 26 * MiB;
constexpr size_t WS_PROJ = 78 * MiB;
constexpr size_t WS_GROUPS = 142 * MiB;
constexpr size_t WS_YC = 174 * MiB;
constexpr size_t WS_YS = 190 * MiB;
constexpr size_t WS_HID = 78 * MiB;
constexpr size_t WS_MODP = 206 * MiB;
constexpr size_t WS_DT = 207 * MiB;
constexpr size_t WS_WDT = 207 * MiB + 512 * 1024;
constexpr size_t WS_PT = 208 * MiB;
constexpr size_t WS_QT = 216 * MiB;
constexpr size_t WS_KT = 224 * MiB;
constexpr size_t WS_US5 = 225 * MiB;
constexpr size_t WS_XS = 233 * MiB;
constexpr size_t WS_CS = 241 * MiB;
constexpr size_t WS_END = 249 * MiB;
constexpr int CW_BAR = 4096;

constexpr int RING_OFF = 0, RING_BYTES = 131072;
constexpr int LDS_BYTES = 147456;
constexpr int LDSCTL_OFF = LDS_BYTES - 512, MISC_OFF = LDSCTL_OFF + 320;
#define GAS __attribute__((address_space(1)))
#define LAS __attribute__((address_space(3)))
typedef unsigned short bf16;
typedef unsigned v4u __attribute__((ext_vector_type(4)));
typedef float f32x4 __attribute__((ext_vector_type(4)));
typedef short bf16x8 __attribute__((ext_vector_type(8)));
typedef GAS unsigned gu32;
typedef GAS unsigned long long gu64;
#define RLX_AGENT __ATOMIC_RELAXED, __HIP_MEMORY_SCOPE_AGENT
#define LDS_WAIT() asm volatile("s_waitcnt lgkmcnt(0)" ::: "memory")
#define VM_WAIT() asm volatile("s_waitcnt vmcnt(0)" ::: "memory")
__device__ __forceinline__ unsigned long long rt() { return __builtin_amdgcn_s_memrealtime(); }
__device__ __forceinline__ unsigned f2bf(float f) { unsigned u = __builtin_bit_cast(unsigned, f); return (u + 0x7fffu + ((u >> 16) & 1u)) >> 16; }
__device__ __forceinline__ unsigned pk2(float lo, float hi) { return f2bf(lo) | (f2bf(hi) << 16); }

#define XB_TMO      128
#define XB_XCNT(j)  (256  + 64 * (j))
#define XB_XSUB(j)  (1280 + 64 * (j))
#define XB_XGEN(j)  (2304 + 64 * (j))
#define XB_TOP      3328
#define XB_TOPGEN   3392
#define XCD_BAR_WORDS 3456
#define XB_SPIN_CAP (1u << 18)

__device__ __forceinline__ unsigned xb_ld(unsigned* p)              { return __hip_atomic_load(p, __ATOMIC_RELAXED, __HIP_MEMORY_SCOPE_AGENT); }
__device__ __forceinline__ unsigned xb_add(unsigned* p, unsigned v) { return __hip_atomic_fetch_add(p, v, __ATOMIC_RELAXED, __HIP_MEMORY_SCOPE_AGENT); }
__device__ __forceinline__ unsigned xb_xcc_id() { return (unsigned)__builtin_amdgcn_s_getreg((3 << 11) | 20) & 0xFu; }
#define XB_SPIN(cond, bar) do { unsigned _sp = 0; while (cond) { __builtin_amdgcn_s_sleep(1); \
    if ((++_sp & 255u) == 0u) { if (xb_ld(&(bar)[XB_TMO])) break; if (_sp > XB_SPIN_CAP) { atomicAdd(&(bar)[XB_TMO], 1u); break; } } } } while (0)

struct XcdBarrier {
    unsigned* bar; unsigned x;
    volatile LAS unsigned* st;
};

__device__ __forceinline__ XcdBarrier xcd_barrier_post(unsigned* bar, volatile LAS unsigned* st) {
    XcdBarrier b; b.bar = bar; b.x = xb_xcc_id(); b.st = st;
    if (threadIdx.x == 0) (void)xb_add(&bar[XB_XCNT(b.x)], 1u);
    return b;
}
__device__ __forceinline__ void xcd_barrier_complete(unsigned* bar, unsigned x, unsigned& nloc, unsigned& nx) {
    const unsigned G = gridDim.x * gridDim.y * gridDim.z;
    unsigned sum, cnt, mine, sp = 0u;
    for (;;) {
        sum = 0u; cnt = 0u; mine = 0u;
#pragma unroll
        for (unsigned j = 0; j < 16; ++j) { const unsigned c = xb_ld(&bar[XB_XCNT(j)]); sum += c; cnt += (c > 0u) ? 1u : 0u; mine = (j == x) ? c : mine; }
        if (sum == G) break;
        __builtin_amdgcn_s_sleep(1);
        if ((++sp & 255u) == 0u) { if (xb_ld(&bar[XB_TMO])) break; if (sp > XB_SPIN_CAP) { atomicAdd(&bar[XB_TMO], 1u); break; } }
    }
    nloc = mine > 0u ? mine : 1u; nx = cnt > 0u ? cnt : 1u;
}

__device__ __forceinline__ void xcd_barrier(const XcdBarrier& b) {
    asm volatile("s_waitcnt vmcnt(0)" ::: "memory");
    __syncthreads();
    if (threadIdx.x == 0) {
        unsigned* bar = b.bar; asm volatile("" : "+s"(bar));
        __builtin_amdgcn_s_waitcnt(0);
        unsigned nloc = b.st[0], nx = b.st[1];
        if (nloc == 0u) { xcd_barrier_complete(bar, b.x, nloc, nx); b.st[0] = nloc; b.st[1] = nx; }
        const unsigned old = xb_add(&bar[XB_XSUB(b.x)], 1u);
        const unsigned gen = old / nloc;
        if (old + 1u == (gen + 1u) * nloc) {
            __builtin_amdgcn_fence(__ATOMIC_RELEASE, "agent");
            asm volatile("s_waitcnt vmcnt(0)" ::: "memory");
            const unsigned og = xb_add(&bar[XB_TOP], 1u);
            const unsigned tg = og / nx;
            if (og + 1u == (tg + 1u) * nx) xb_add(&bar[XB_TOPGEN], 1u);
            else XB_SPIN(xb_ld(&bar[XB_TOPGEN]) == tg, bar);
            __builtin_amdgcn_fence(__ATOMIC_ACQUIRE, "agent");
            xb_add(&bar[XB_XGEN(b.x)], 1u);
            asm volatile("s_waitcnt vmcnt(0)" ::: "memory");
        } else {
            XB_SPIN(xb_ld(&bar[XB_XGEN(b.x)]) == gen, bar);
            __builtin_amdgcn_fence(__ATOMIC_ACQUIRE, "agent");
            asm volatile("s_waitcnt vmcnt(0)" ::: "memory");
        }
    }
    __syncthreads();
}

struct Frame {
    LAS unsigned char* lds;
    volatile LAS unsigned* MISC;
    gu32* ctl;
    int tid, lane, wave;
    int vcu, G;
    const __attribute__((address_space(4))) unsigned char* karg;
    unsigned char* ws;
};
#define FIN(i) (*(const float* const __attribute__((address_space(4)))*)(F.karg + 8 * (i)))
#define F_H (*(float* const __attribute__((address_space(4)))*)(F.karg + 8 * N_IN))
#define F_WinT ((bf16*)(F.ws + WS_WIN))
#define F_WoutT ((bf16*)(F.ws + WS_WOUT))
#define F_W1T ((bf16*)(F.ws + WS_W1))
#define F_W2T ((bf16*)(F.ws + WS_W2))
#define F_UV ((bf16*)(F.ws + WS_UV))
#define F_PROJ ((bf16*)(F.ws + WS_PROJ))
#define F_GROUPS ((bf16*)(F.ws + WS_GROUPS))
#define F_HID ((bf16*)(F.ws + WS_HID))
#define F_YC ((float*)(F.ws + WS_YC))
#define F_YS ((float*)(F.ws + WS_YS))
#define F_MODP ((float*)(F.ws + WS_MODP))
#define F_DT ((float*)(F.ws + WS_DT))
#define F_WDT ((float*)(F.ws + WS_WDT))
#define F_PT ((bf16*)(F.ws + WS_PT))
#define F_QT ((bf16*)(F.ws + WS_QT))
#define F_KT ((bf16*)(F.ws + WS_KT))
#define F_US5 ((bf16*)(F.ws + WS_US5))
#define F_SEND ((float*)(F.ws + WS_SEND))
#define F_ST ((float*)(F.ws + WS_ST))
#define F_PREV ((bf16*)(F.ws + WS_PREV))
#define F_ACS ((float*)(F.ws + WS_ACS))
#define F_XS ((bf16*)(F.ws + WS_XS))
#define F_CS ((bf16*)(F.ws + WS_CS))

__device__ __forceinline__ float wave_sum(float v) {
#pragma unroll
    for (int o = 1; o < 64; o <<= 1) v += __shfl_xor(v, o);
    return v;
}
__device__ __forceinline__ int opq(int x) { asm volatile("" : "+v"(x)); return x; }
__device__ __forceinline__ float bf2f(bf16 h) { return __uint_as_float(((unsigned)h) << 16); }
__device__ __forceinline__ float siluf(float x) { return x / (1.f + __expf(-x)); }
__device__ __forceinline__ float sigmf(float x) { return 1.f / (1.f + __expf(-x)); }
__device__ __forceinline__ float softplusf(float x) { return x > 20.f ? x : log1pf(__expf(x)); }
__device__ __forceinline__ float gelu_tanh(float x) { const float t = tanhf(0.7978845608028654f * (x + 0.044715f * x * x * x)); return 0.5f * x * (1.f + t); }

__device__ __forceinline__ f32x4 modv4(const Frame& F, int l, int b, int idx, int col) {
    const float* q = F_MODP + ((size_t)l * 2 + b) * MOD + idx * D + col; constexpr size_t PS = (size_t)2 * 2 * MOD;
    return *(const f32x4*)(FIN(I_ADAB) + (size_t)l * MOD + idx * D + col) + ((*(const f32x4*)q + *(const f32x4*)(q + PS)) + (*(const f32x4*)(q + 2 * PS) + *(const f32x4*)(q + 3 * PS)));
}

__device__ __forceinline__ void p0_transpose_item(const float* W, int K, int Nsrc, int nblk, int shift_from, int shift, bf16* WT, LAS float* scr, int item, int lane) {
    const int kb = item / nblk, nb = item % nblk, k0 = 64 * kb, n0 = 32 * nb, n0s = n0 + (n0 >= shift_from ? shift : 0);
#pragma unroll 8
    for (int i = 0; i < 32; ++i) { const int kk = 2 * i + (lane >> 5); scr[kk * 33 + (lane & 31)] = W[(size_t)(k0 + kk) * Nsrc + n0s + (lane & 31)]; }
    LDS_WAIT(); asm volatile("" ::: "memory");
    const int c = lane & 7;
#pragma unroll
    for (int j = 0; j < 4; ++j) { const int n = (lane >> 3) + 8 * j; const LAS float* s = scr + (8 * c) * 33 + n;
        v4u o; o.x = pk2(s[0 * 33], s[1 * 33]); o.y = pk2(s[2 * 33], s[3 * 33]); o.z = pk2(s[4 * 33], s[5 * 33]); o.w = pk2(s[6 * 33], s[7 * 33]);
        *(GAS v4u*)(WT + (size_t)(n0 + n) * K + k0 + 8 * c) = o; }
    LDS_WAIT(); asm volatile("" ::: "memory");
}

__device__ __forceinline__ void p0_prologue(Frame& F) {
    if (F.vcu < 192) {
        const int l = F.vcu / 96, rem = F.vcu % 96, cb = rem / 4, kq = rem % 4;
        const float* W = FIN(I_ADAW) + (size_t)l * D * MOD + cb * 256 + 4 * F.lane; const float* c = FIN(I_C);
        f32x4 a0 = {0.f, 0.f, 0.f, 0.f}, a1 = {0.f, 0.f, 0.f, 0.f};
        const int kbeg = kq * 256 + F.wave * 32;
#pragma unroll 8
        for (int k = kbeg; k < kbeg + 32; ++k) { const f32x4 w = *(const f32x4*)(W + (size_t)k * MOD); const float c0 = siluf(c[k]), c1 = siluf(c[D + k]); a0 += w * c0; a1 += w * c1; }
        LAS f32x4* red = (LAS f32x4*)(F.lds);
        red[(F.wave * 64 + F.lane) * 2 + 0] = a0; red[(F.wave * 64 + F.lane) * 2 + 1] = a1;
        __syncthreads();
        if (F.wave == 0) {
            f32x4 s0 = {0.f, 0.f, 0.f, 0.f}, s1 = {0.f, 0.f, 0.f, 0.f};
#pragma unroll
            for (int w = 0; w < 8; ++w) { s0 += red[(w * 64 + F.lane) * 2 + 0]; s1 += red[(w * 64 + F.lane) * 2 + 1]; }
            float* o = F_MODP + ((size_t)(kq * 2 + l) * 2) * MOD + cb * 256 + 4 * F.lane;
            *(f32x4*)o = s0; *(f32x4*)(o + MOD) = s1;
        }
        __syncthreads();
    }
    LAS float* scr = (LAS float*)(F.lds + RING_OFF + F.wave * 16384);
    const int gw = F.vcu * NWAVES + F.wave, NGW = F.G * NWAVES;
    for (int idx = gw * 64 + F.lane; idx < DEPTH * 16 * 64 * 64; idx += NGW * 64) {
        const int s = idx & 63, pp = (idx >> 6) & 63, lg = idx >> 12;
        const float are = FIN(I_S5ARE)[lg * 64 + pp], aim = FIN(I_S5AIM)[lg * 64 + pp], step = expf(FIN(I_S5LS)[lg]);
        const float mag = expf(are * step), lr = mag * cosf(aim * step), li = mag * sinf(aim * step);
        const float den = are * are + aim * aim, nr = lr - 1.0f, fre = (nr * are + li * aim) / den, fim = (li * are - nr * aim) / den;
        const float e1 = (float)(63 - s), m1 = expf(e1 * are * step), zr = m1 * cosf(e1 * aim * step), zi = m1 * sinf(e1 * aim * step);
        const float zfr = zr * fre - zi * fim, zfi = zr * fim + zi * fre;
        bf16* pt0 = F_PT + ((size_t)lg * 128 + 2 * pp) * 1024 + s * 16;
#pragma unroll
        for (int h = 0; h < 16; h += 2) { const float br0 = FIN(I_S5BRE)[((size_t)lg * 64 + pp) * 16 + h], bi0 = FIN(I_S5BIM)[((size_t)lg * 64 + pp) * 16 + h];
            const float br1 = FIN(I_S5BRE)[((size_t)lg * 64 + pp) * 16 + h + 1], bi1 = FIN(I_S5BIM)[((size_t)lg * 64 + pp) * 16 + h + 1];
            *(unsigned*)(pt0 + h) = pk2(zfr * br0 - zfi * bi0, zfr * br1 - zfi * bi1);
            *(unsigned*)(pt0 + 1024 + h) = pk2(zfr * bi0 + zfi * br0, zfr * bi1 + zfi * br1); }
        const float e2 = (float)(s + 1), m2 = expf(e2 * are * step), yr = m2 * cosf(e2 * aim * step), yi = m2 * sinf(e2 * aim * step);
#pragma unroll
        for (int h = 0; h < 16; ++h) { const float cr = FIN(I_S5CRE)[((size_t)lg * 16 + h) * 64 + pp], ci = FIN(I_S5CIM)[((size_t)lg * 16 + h) * 64 + pp];
            *(unsigned*)(F_QT + ((size_t)lg * 1024 + s * 16 + h) * 128 + 2 * pp) = pk2(cr * yr - ci * yi, -(cr * yi + ci * yr)); }
    }
    for (int it = gw; it < DEPTH * 16 * 64; it += NGW) {
        const int d = it & 63, lg = it >> 6, pp = F.lane;
        { const float are = FIN(I_S5ARE)[lg * 64 + pp], aim = FIN(I_S5AIM)[lg * 64 + pp], step = expf(FIN(I_S5LS)[lg]);
          const float mag = expf(are * step), lr = mag * cosf(aim * step), li = mag * sinf(aim * step);
          const float den = are * are + aim * aim, nr = lr - 1.0f, fre = (nr * are + li * aim) / den, fim = (li * are - nr * aim) / den;
          const float e1 = (float)d, m1 = expf(e1 * are * step), zr = m1 * cosf(e1 * aim * step), zi = m1 * sinf(e1 * aim * step);
          scr[2 * pp] = zr * fre - zi * fim; scr[2 * pp + 1] = zr * fim + zi * fre; }
        LDS_WAIT(); asm volatile("" ::: "memory");
        const int h = F.lane >> 2, k0 = (F.lane & 3) * 4;
        float o[4] = {0.f, 0.f, 0.f, 0.f};
        for (int p2 = 0; p2 < 64; ++p2) {
            const float zr = scr[2 * p2], zi = scr[2 * p2 + 1];
            const float cr = FIN(I_S5CRE)[((size_t)lg * 16 + h) * 64 + p2], ci = FIN(I_S5CIM)[((size_t)lg * 16 + h) * 64 + p2];
            const f32x4 br = *(const f32x4*)(FIN(I_S5BRE) + ((size_t)lg * 64 + p2) * 16 + k0), bi = *(const f32x4*)(FIN(I_S5BIM) + ((size_t)lg * 64 + p2) * 16 + k0);
#pragma unroll
            for (int e = 0; e < 4; ++e) { const float tr = zr * br[e] - zi * bi[e], ti = zr * bi[e] + zi * br[e]; o[e] += cr * tr - ci * ti; }
        }
        *(unsigned long long*)(F_KT + ((size_t)lg * 64 + d) * 256 + h * 16 + k0) = (unsigned long long)pk2(o[0], o[1]) | ((unsigned long long)pk2(o[2], o[3]) << 32);
        LDS_WAIT(); asm volatile("" ::: "memory");
    }
    for (int i = gw * 64 + F.lane; i < DEPTH * D; i += NGW * 64) { const int l = i / D, k = i % D;
        *(f32x4*)(F_WDT + (size_t)i * 4) = *(const f32x4*)(FIN(I_WIN) + ((size_t)l * D + k) * NPROJ_SRC + 2048); }
    constexpr int I_IN = (D / 64) * (NPROJ / 32), I_O = (D / 64) * (D / 32), I_1 = (D / 64) * (FF / 32), I_2 = (FF / 64) * (D / 32), I_L = I_IN + I_O + I_1 + I_2;
    for (int it = gw; it < DEPTH * I_L; it += NGW) {
        const int l = it / I_L; int r = it % I_L;
        if (r < I_IN) { p0_transpose_item(FIN(I_WIN) + (size_t)l * D * NPROJ_SRC, D, NPROJ_SRC, NPROJ / 32, 2048, 4, F_WinT + (size_t)l * NPROJ * D, scr, r, F.lane); continue; } r -= I_IN;
        if (r < I_O) { p0_transpose_item(FIN(I_WOUT) + (size_t)l * D * D, D, D, D / 32, 1 << 30, 0, F_WoutT + (size_t)l * D * D, scr, r, F.lane); continue; } r -= I_O;
        if (r < I_1) { p0_transpose_item(FIN(I_W1) + (size_t)l * D * FF, D, FF, FF / 32, 1 << 30, 0, F_W1T + (size_t)l * FF * D, scr, r, F.lane); continue; } r -= I_1;
        p0_transpose_item(FIN(I_W2) + (size_t)l * FF * D, FF, D, D / 32, 1 << 30, 0, F_W2T + (size_t)l * D * FF, scr, r, F.lane);
    }
}

__device__ __forceinline__ void norm_phase(Frame& F, const float* src, const float* nw, int l, int sh_idx, int sc_idx, bf16* dst, bool do_dt) {
    const int gw = F.vcu * NWAVES + F.wave, NGW = F.G * NWAVES, lane = opq(F.lane);
    for (int blk = gw; blk < M / 8; blk += NGW) {
        const int m0 = blk * 8, b = m0 / SEQ;
        f32x4 nwv[4], shv[4], scv[4];
#pragma unroll
        for (int j = 0; j < 4; ++j) { const int col = 4 * lane + 256 * j; nwv[j] = *(const f32x4*)(nw + col); shv[j] = modv4(F, l, b, sh_idx, col); scv[j] = modv4(F, l, b, sc_idx, col) + 1.0f;
            asm volatile("" : "+v"(shv[j]), "+v"(scv[j]) :: "memory"); }
        for (int i = 0; i < 8; ++i) {
            const int m = m0 + i;
            const f32x4* xr = (const f32x4*)(src + (size_t)m * D) + lane;
            f32x4 v[4]; float ss = 0.f;
#pragma unroll
            for (int j = 0; j < 4; ++j) { v[j] = xr[64 * j]; ss += (v[j].x * v[j].x + v[j].y * v[j].y) + (v[j].z * v[j].z + v[j].w * v[j].w); }
            const float r = 1.0f / sqrtf(wave_sum(ss) * (1.0f / D) + EPS);
            unsigned long long* o8 = (unsigned long long*)(dst + (size_t)m * D) + lane;
#pragma unroll
            for (int j = 0; j < 4; ++j) { v[j] = (v[j] * r) * nwv[j] * scv[j] + shv[j];
                o8[64 * j] = (unsigned long long)pk2(v[j].x, v[j].y) | ((unsigned long long)pk2(v[j].z, v[j].w) << 32); }
            if (do_dt) {
                const float* wdt = F_WDT + (size_t)l * D * 4 + 16 * lane;
                f32x4 d = {0.f, 0.f, 0.f, 0.f};
#pragma unroll
                for (int j = 0; j < 4; ++j)
#pragma unroll
                    for (int e = 0; e < 4; ++e) d += *(const f32x4*)(wdt + (256 * j + e) * 4) * v[j][e];
                d.x = wave_sum(d.x); d.y = wave_sum(d.y); d.z = wave_sum(d.z); d.w = wave_sum(d.w);
                if (lane == 0) *(f32x4*)(F_DT + (size_t)m * 4) = d;
            }
        }
    }
}

__device__ __forceinline__ void final_norm_phase(Frame& F) {
    const int gw = F.vcu * NWAVES + F.wave, NGW = F.G * NWAVES, lane = opq(F.lane); const float* nw = FIN(I_FNW);
    f32x4 nwv[4];
#pragma unroll
    for (int j = 0; j < 4; ++j) nwv[j] = *(const f32x4*)(nw + 4 * lane + 256 * j);
    for (int m = gw; m < M; m += NGW) {
        f32x4* xr = (f32x4*)(F_H + (size_t)m * D) + lane;
        f32x4 v[4]; float ss = 0.f;
#pragma unroll
        for (int j = 0; j < 4; ++j) { v[j] = xr[64 * j]; ss += (v[j].x * v[j].x + v[j].y * v[j].y) + (v[j].z * v[j].z + v[j].w * v[j].w); }
        const float r = 1.0f / sqrtf(wave_sum(ss) * (1.0f / D) + EPS);
#pragma unroll
        for (int j = 0; j < 4; ++j) xr[64 * j] = (v[j] * r) * nwv[j];
    }
}

__device__ __forceinline__ void x1_pool_sconv(Frame& F, int l) {
    const int gw = F.vcu * NWAVES + F.wave, NGW = F.G * NWAVES, lane = opq(F.lane);
    LAS float* ps = (LAS float*)(F.lds + RING_OFF + F.wave * 16384);
    const float* pw = FIN(I_POOLW) + (size_t)l * 4 * 64 * 64; const float* pscale = FIN(I_POOLS) + l * 256; const float* bnw = FIN(I_BNW) + l * D;
    const float* sw = FIN(I_SCONVW) + (size_t)l * 3 * 256;
    for (int blk = gw; blk < M / 8; blk += NGW) {
        const int m0 = blk * 8;
        {
            float s[8][4], v0[8][4];
#pragma unroll
            for (int tok = 0; tok < 8; ++tok)
#pragma unroll
                for (int g = 0; g < 4; ++g) { s[tok][g] = 0.f; v0[tok][g] = 0.f; }
            const int t0 = m0 & (SEQ - 1);
#pragma unroll 1
            for (int rr = -15; rr < 8; ++rr) {
                if (t0 + rr < 0) continue;
                const bf16* row = F_PROJ + (size_t)(m0 + rr) * NPP + PC_POOL + lane;
                float x[4];
#pragma unroll
                for (int g = 0; g < 4; ++g) x[g] = bf2f(row[g * 64]);
#pragma unroll
                for (int tok = 0; tok < 8; ++tok) { const int j = tok - rr;
#pragma unroll
                    for (int g = 0; g < 4; ++g) { const bool in = (j >= 0) && (j < (2 << g)); s[tok][g] += in ? x[g] : 0.f; v0[tok][g] = (j == 0) ? x[g] : v0[tok][g]; } }
            }
#pragma unroll
            for (int tok = 0; tok < 8; ++tok) { const int t = t0 + tok;
#pragma unroll
                for (int g = 0; g < 4; ++g) { const int win = 2 << g, cnt = (t + 1 < win) ? (t + 1) : win; ps[tok * 256 + g * 64 + lane] = s[tok][g] / (float)cnt - v0[tok][g]; } }
        }
        LDS_WAIT(); asm volatile("" ::: "memory");
        float acc[8][4];
#pragma unroll
        for (int tok = 0; tok < 8; ++tok)
#pragma unroll
            for (int g = 0; g < 4; ++g) acc[tok][g] = 0.f;
        for (int c = 0; c < 64; ++c) {
            float w[4];
#pragma unroll
            for (int g = 0; g < 4; ++g) w[g] = pw[(size_t)(g * 64 + c) * 64 + lane];
#pragma unroll
            for (int tok = 0; tok < 8; ++tok)
#pragma unroll
                for (int g = 0; g < 4; ++g) acc[tok][g] += ps[tok * 256 + g * 64 + c] * w[g];
        }
        LDS_WAIT(); asm volatile("" ::: "memory");
#pragma unroll
        for (int tok = 0; tok < 8; ++tok) {
            const int m = m0 + tok; float y[4], ss = 0.f;
#pragma unroll
            for (int g = 0; g < 4; ++g) { y[g] = acc[tok][g] * pscale[g * 64 + lane]; ss += y[g] * y[g]; }
            const float r = 1.0f / sqrtf(wave_sum(ss) * (1.0f / 256.f) + EPS);
#pragma unroll
            for (int g = 0; g < 4; ++g) F_GROUPS[(size_t)m * D + g * 64 + lane] = (bf16)f2bf(y[g] * r * bnw[g * 64 + lane]);
        }
        for (int tok = 0; tok < 8; ++tok) {
            const int m = m0 + tok, t = m & (SEQ - 1); float y[4], ss = 0.f;
#pragma unroll
            for (int j = 0; j < 4; ++j) {
                const int c = lane + 64 * j; const bf16* row = F_PROJ + (size_t)m * NPP;
                float a = 0.f;
#pragma unroll
                for (int k = 0; k < 3; ++k) { const int back = 2 - k; const bool ok = t >= back; const bf16* rr = row - (ok ? (size_t)back * NPP : 0);
                    const float gc = bf2f(rr[PC_GC + c]), hh = bf2f(rr[PC_H + c]); a += ok ? sw[k * 256 + c] * (gc * hh) : 0.f; }
                y[j] = bf2f(row[PC_GB + c]) * a; ss += y[j] * y[j];
            }
            const float r = 1.0f / sqrtf(wave_sum(ss) * (1.0f / 256.f) + EPS);
#pragma unroll
            for (int j = 0; j < 4; ++j) { const int c = lane + 64 * j; F_GROUPS[(size_t)m * D + 256 + c] = (bf16)f2bf(y[j] * r * bnw[256 + c]); }
        }
    }
}

typedef float f32x16 __attribute__((ext_vector_type(16)));
__device__ __forceinline__ void s5_send_item(Frame& F, int l, int j) {
    const int lane = opq(F.lane), c = lane & 31, hh = lane >> 5;
    const int g = j >> 5, mt = (j >> 2) & 7, nt = j & 3;
    const bf16* A = F_US5 + ((size_t)g * M + (size_t)(mt * 32 + c) * 64) * 16 + 8 * hh;
    const bf16* Bt = F_PT + ((size_t)(l * 16 + g) * 128 + nt * 32 + c) * 1024 + 8 * hh;
    f32x16 acc;
#pragma unroll
    for (int r = 0; r < 16; ++r) acc[r] = 0.f;
#pragma unroll 16
    for (int s = 0; s < 64; ++s) acc = __builtin_amdgcn_mfma_f32_32x32x16_bf16(*(const bf16x8*)(A + s * 16), *(const bf16x8*)(Bt + s * 16), acc, 0, 0, 0);
#pragma unroll
    for (int r = 0; r < 16; ++r) { const int row = mt * 32 + (r & 3) + 8 * (r >> 2) + 4 * hh; F_SEND[((size_t)g * NCHR + row) * 128 + nt * 32 + c] = acc[r]; }
}
constexpr int XB_KT = 0, XB_A = 32768, XB_AP = 2064, XB_SP = XB_A + 32 * XB_AP, XB_SC = XB_SP + 32 * 136 * 2;
static_assert(XB_SC + 8 * 64 * 8 <= LDSCTL_OFF, "XB LDS map");
__device__ __forceinline__ void s5_xb_item(Frame& F, int l, int b, int g, int mt, int th) {
    const int lane = opq(F.lane), wave = F.wave, c = lane & 31, hh = lane >> 5, lg = l * 16 + g;
    LAS bf16* sp = (LAS bf16*)(F.lds + XB_SP);
    typedef float f32x2v __attribute__((ext_vector_type(2)));
    LAS f32x2v* Tw = (LAS f32x2v*)(F.lds + XB_SC);
    const int crow0 = b * 128 + mt * 32;
    const int tid = wave * 64 + lane;
    { const v4u* ks = (const v4u*)(F_KT + (size_t)lg * 64 * 256); LAS v4u* kd = (LAS v4u*)(F.lds + XB_KT);
#pragma unroll
      for (int i = 0; i < 4; ++i) kd[tid + 512 * i] = ks[tid + 512 * i];
      const v4u* as = (const v4u*)(F_US5 + ((size_t)g * M + (size_t)crow0 * 64) * 16);
#pragma unroll
      for (int i = 0; i < 8; ++i) { const int q = tid + 512 * i, row = q >> 7, col = q & 127; *(LAS v4u*)(F.lds + XB_A + row * XB_AP + col * 16) = as[q]; } }
    float l64r, l64i;
    { const float are = FIN(I_S5ARE)[lg * 64 + lane], aim = FIN(I_S5AIM)[lg * 64 + lane], step = expf(FIN(I_S5LS)[lg]);
      const float m64 = expf(64.f * are * step); l64r = m64 * cosf(64.f * aim * step); l64i = m64 * sinf(64.f * aim * step); }
    float Lr[16], Li[16];
    { const float* se = F_SEND + ((size_t)g * NCHR + b * 128 + wave * 16) * 128 + 2 * lane;
      float er[16], ei[16];
#pragma unroll
      for (int i = 0; i < 16; ++i) { const f32x2v q = *(const f32x2v*)(se + (size_t)i * 128); er[i] = q.x; ei[i] = q.y; }
      float cr = 0.f, ci = 0.f;
#pragma unroll
      for (int i = 0; i < 16; ++i) { Lr[i] = cr; Li[i] = ci; const float nr = l64r * cr - l64i * ci + er[i], ni = l64r * ci + l64i * cr + ei[i]; cr = nr; ci = ni; }
      Tw[wave * 64 + lane] = (f32x2v){cr, ci}; }
    __syncthreads();
    if ((wave >> 1) == mt) {
        float pr = l64r, pi = l64i;
#pragma unroll
        for (int i = 0; i < 4; ++i) { const float nr = pr * pr - pi * pi, ni = 2.f * pr * pi; pr = nr; pi = ni; }
        float cr = 0.f, ci = 0.f;
        for (int w = 0; w < wave; ++w) { const f32x2v t = Tw[w * 64 + lane]; const float nr = pr * cr - pi * ci + t.x, ni = pr * ci + pi * cr + t.y; cr = nr; ci = ni; }
        float qr = 1.f, qi = 0.f;
#pragma unroll
        for (int i = 0; i < 16; ++i) { const float sr = Lr[i] + qr * cr - qi * ci, si = Li[i] + qr * ci + qi * cr;
            *(LAS unsigned*)(sp + ((wave & 1) * 16 + i) * 136 + 2 * lane) = pk2(sr, si);
            const float nr = qr * l64r - qi * l64i, ni = qr * l64i + qi * l64r; qr = nr; qi = ni; }
    }
    __syncthreads();
    const float dsk = FIN(I_S5D)[l * 256 + g * 16 + (c & 15)];
    bf16x8 af[8];
#pragma unroll
    for (int k = 0; k < 8; ++k) af[k] = *(const LAS bf16x8*)(sp + c * 136 + k * 16 + 8 * hh);
    const LAS unsigned char* Al = F.lds + XB_A + c * XB_AP + 16 * hh;
    const LAS unsigned char* Kl = F.lds + XB_KT + (c & 15) * 32 + 16 * hh;
    const bf16x8 zero = {0, 0, 0, 0, 0, 0, 0, 0};
#pragma unroll 1
    for (int i = 0; i < 2; ++i) {
        const int q = wave, tb = th ? ((i == 0) ? 15 - q : 16 + q) : ((i == 0) ? q : 31 - q);
        const int t = 2 * tb + (c >> 4), h = c & 15;
        const bf16* Bt = F_QT + ((size_t)lg * 1024 + tb * 32 + c) * 128 + 8 * hh;
        f32x16 acc;
#pragma unroll
        for (int r = 0; r < 16; ++r) acc[r] = 0.f;
#pragma unroll
        for (int k = 0; k < 8; ++k) acc = __builtin_amdgcn_mfma_f32_32x32x16_bf16(af[k], *(const bf16x8*)(Bt + k * 16), acc, 0, 0, 0);
        const int ns = 2 * tb + 2;
#pragma unroll 4
        for (int s = 0; s < ns; ++s) {
            const int d = t - s; const bf16x8 bl = *(const LAS bf16x8*)(Kl + (d < 0 ? 0 : d) * 512); const bf16x8 bq = (d >= 0) ? bl : zero;
            acc = __builtin_amdgcn_mfma_f32_32x32x16_bf16(*(const LAS bf16x8*)(Al + s * 32), bq, acc, 0, 0, 0);
        }
#pragma unroll
        for (int r = 0; r < 16; ++r) { const int row = crow0 + (r & 3) + 8 * (r >> 2) + 4 * hh; const size_t tok = (size_t)row * 64 + t;
            F_YS[tok * 256 + g * 16 + h] = acc[r] + dsk * bf2f(F_US5[((size_t)g * M + tok) * 16 + h]); }
    }
    __syncthreads();
}

constexpr int SPB = 272;
constexpr int SS_CM = 0, SS_BM = 128 * SPB, SS_XDT = 2 * 128 * SPB, SS_XDE = 3 * 128 * SPB, SS_F32 = 4 * 128 * SPB;
static_assert(SS_F32 + 3 * 2 * 128 * 4 <= LDSCTL_OFF, "SSD unit LDS map");
typedef short s16x4v __attribute__((ext_vector_type(4)));
__device__ __forceinline__ bf16x8 tr_frag(const LAS unsigned char* img, int k0, int n0, int lane) {
    const int i = lane & 15, q = lane >> 4;
    const LAS unsigned char* a = img + (k0 + 4 * (q >> 1) + (i >> 2)) * SPB + (n0 + 16 * (q & 1) + 4 * (i & 3)) * 2;
    const s16x4v lo = __builtin_bit_cast(s16x4v, __builtin_amdgcn_ds_read_tr16_b64_v4i16((LAS s16x4v*)a));
    const s16x4v hi = __builtin_bit_cast(s16x4v, __builtin_amdgcn_ds_read_tr16_b64_v4i16((LAS s16x4v*)(a + 8 * SPB)));
    return (bf16x8){lo[0], lo[1], lo[2], lo[3], hi[0], hi[1], hi[2], hi[3]};
}
__device__ __forceinline__ void ssd_chunk_unit(Frame& F, int l, int b, int cc, int g) {
    const int lane = opq(F.lane), wave = F.wave, c = lane & 31, hh = lane >> 5, tid = wave * 64 + lane;
    const int m0 = b * SEQ + cc * 128;
    const LAS unsigned char* Cm = F.lds + SS_CM; const LAS unsigned char* Bm = F.lds + SS_BM; const LAS unsigned char* Xdt = F.lds + SS_XDT; const LAS unsigned char* Xde = F.lds + SS_XDE;
    LAS float* dts = (LAS float*)(F.lds + SS_F32); LAS float* acs = dts + 256; LAS float* dte = dts + 512;
    if (wave < 2) {
        const int h = 2 * g + wave;
        const float dtb = FIN(I_DTB)[l * 4 + h], a = -__expf(FIN(I_ALOG)[l * 4 + h]);
        const float d0 = softplusf(F_DT[(size_t)(m0 + lane) * 4 + h] + dtb), d1 = softplusf(F_DT[(size_t)(m0 + 64 + lane) * 4 + h] + dtb);
        float v0 = a * d0, v1 = a * d1;
#pragma unroll
        for (int o = 1; o < 64; o <<= 1) { const float t0 = __shfl_up(v0, o), t1 = __shfl_up(v1, o); if (lane >= o) { v0 += t0; v1 += t1; } }
        v1 += __shfl(v0, 63);
        const float aend = __shfl(v1, 63);
        dts[wave * 128 + lane] = d0; dts[wave * 128 + 64 + lane] = d1; acs[wave * 128 + lane] = v0; acs[wave * 128 + 64 + lane] = v1;
        dte[wave * 128 + lane] = __expf(aend - v0); dte[wave * 128 + 64 + lane] = __expf(aend - v1);
        F_ACS[(size_t)(m0 + lane) * 4 + h] = v0; F_ACS[(size_t)(m0 + 64 + lane) * 4 + h] = v1;
    }
    __syncthreads();
    if (tid < 480) {
        const int o = tid % 48, tg = tid / 48, t0 = tg * 13, nt = (t0 + 13 <= 128) ? 13 : (128 - t0);
        const int cho = (o < 16) ? (g * 128 + o * 8) : (o < 32) ? (256 + g * 128 + (o - 16) * 8) : (512 + g * 128 + (o - 32) * 8);
        const float* cw = FIN(I_SSDCW) + (size_t)l * 4 * 768 + cho; const float* cbias = FIN(I_SSDCB) + (size_t)l * 768 + cho;
        float w[4][8], bs[8];
#pragma unroll
        for (int k = 0; k < 4; ++k) { const f32x4 a0 = *(const f32x4*)(cw + k * 768), a1 = *(const f32x4*)(cw + k * 768 + 4);
#pragma unroll
            for (int e = 0; e < 4; ++e) { w[k][e] = a0[e]; w[k][4 + e] = a1[e]; } }
        { const f32x4 a0 = *(const f32x4*)cbias, a1 = *(const f32x4*)(cbias + 4);
#pragma unroll
          for (int e = 0; e < 4; ++e) { bs[e] = a0[e]; bs[4 + e] = a1[e]; } }
        const bf16* src = F_PROJ + (size_t)(m0 + t0) * NPP + PC_X + cho;
        const int tseq = cc * 128 + t0;
        v4u raw[16];
#pragma unroll
        for (int i = 0; i < 16; ++i) { const bool ok = (tseq + i - 3 >= 0) && (i - 3 < nt); raw[i] = ok ? *(const v4u*)(src + (long)(i - 3) * NPP) : (v4u){0u, 0u, 0u, 0u}; }
        const int hd = o >> 3;
        LAS unsigned char* img = F.lds + ((o < 16) ? SS_XDT : (o < 32) ? SS_BM : SS_CM) + ((o & 15) * 8) * 2;
#pragma unroll
        for (int i = 0; i < 13; ++i) {
            if (i < nt) {
                const int tl = t0 + i; float v[8];
#pragma unroll
                for (int e = 0; e < 8; ++e) {
                    float acc = bs[e];
#pragma unroll
                    for (int k = 0; k < 4; ++k) { const unsigned wd = raw[i + k][e >> 1]; const float x = (e & 1) ? __uint_as_float(wd & 0xffff0000u) : __uint_as_float(wd << 16); acc += w[k][e] * x; }
                    v[e] = siluf(acc);
                }
                if (o < 16) {
                    *(v4u*)(F_XS + (size_t)(m0 + tl) * 256 + g * 128 + o * 8) = (v4u){pk2(v[0], v[1]), pk2(v[2], v[3]), pk2(v[4], v[5]), pk2(v[6], v[7])};
                    const float sd = dts[hd * 128 + tl], se = sd * dte[hd * 128 + tl];
                    *(LAS v4u*)(img + tl * SPB) = (v4u){pk2(v[0] * sd, v[1] * sd), pk2(v[2] * sd, v[3] * sd), pk2(v[4] * sd, v[5] * sd), pk2(v[6] * sd, v[7] * sd)};
                    *(LAS v4u*)(img + (SS_XDE - SS_XDT) + tl * SPB) = (v4u){pk2(v[0] * se, v[1] * se), pk2(v[2] * se, v[3] * se), pk2(v[4] * se, v[5] * se), pk2(v[6] * se, v[7] * se)};
                } else {
                    const v4u q = (v4u){pk2(v[0], v[1]), pk2(v[2], v[3]), pk2(v[4], v[5]), pk2(v[6], v[7])};
                    *(LAS v4u*)(img + tl * SPB) = q;
                    if (o >= 32) *(v4u*)(F_CS + (size_t)(m0 + tl) * 256 + g * 128 + (o - 32) * 8) = q;
                }
            }
        }
    }
    __syncthreads();
    {
        const int j = wave & 3, pt = wave >> 2;
        bf16x8 cf[8];
#pragma unroll
        for (int ks = 0; ks < 8; ++ks) cf[ks] = *(const LAS bf16x8*)(Cm + (j * 32 + c) * SPB + (ks * 16 + 8 * hh) * 2);
        const float al0 = acs[j * 32 + c], al1 = acs[128 + j * 32 + c];
        f32x16 y0, y1;
#pragma unroll
        for (int r = 0; r < 16; ++r) { y0[r] = 0.f; y1[r] = 0.f; }
        for (int i = 0; i <= j; ++i) {
            f32x16 X;
#pragma unroll
            for (int r = 0; r < 16; ++r) X[r] = 0.f;
#pragma unroll
            for (int ks = 0; ks < 8; ++ks) X = __builtin_amdgcn_mfma_f32_32x32x16_bf16(*(const LAS bf16x8*)(Bm + (i * 32 + c) * SPB + (ks * 16 + 8 * hh) * 2), cf[ks], X, 0, 0, 0);
            f32x16 X0, X1;
#pragma unroll
            for (int r = 0; r < 16; ++r) { const int s = i * 32 + (r & 3) + 8 * (r >> 2) + 4 * hh; const bool ok = (s <= j * 32 + c);
                X0[r] = ok ? X[r] * __expf(al0 - acs[s]) : 0.f; X1[r] = ok ? X[r] * __expf(al1 - acs[128 + s]) : 0.f; }
#pragma unroll
            for (int ks2 = 0; ks2 < 2; ++ks2) {
                bf16x8 xa0, xa1; unsigned* w0 = (unsigned*)&xa0; unsigned* w1 = (unsigned*)&xa1;
#pragma unroll
                for (int e = 0; e < 4; ++e) { w0[e] = pk2(X0[8 * ks2 + 2 * e], X0[8 * ks2 + 2 * e + 1]); w1[e] = pk2(X1[8 * ks2 + 2 * e], X1[8 * ks2 + 2 * e + 1]); }
                y0 = __builtin_amdgcn_mfma_f32_32x32x16_bf16(xa0, tr_frag(Xdt, i * 32 + 16 * ks2, pt * 32, lane), y0, 0, 0, 0);
                y1 = __builtin_amdgcn_mfma_f32_32x32x16_bf16(xa1, tr_frag(Xdt, i * 32 + 16 * ks2, 64 + pt * 32, lane), y1, 0, 0, 0);
            }
        }
#pragma unroll
        for (int r = 0; r < 16; ++r) { const int tl = j * 32 + (r & 3) + 8 * (r >> 2) + 4 * hh; float* yo = F_YC + (size_t)(m0 + tl) * 256 + g * 128 + pt * 32 + c; yo[0] = y0[r]; yo[64] = y1[r]; }
#pragma unroll
        for (int hd = 0; hd < 2; ++hd) {
            f32x16 st;
#pragma unroll
            for (int r = 0; r < 16; ++r) st[r] = 0.f;
#pragma unroll
            for (int ks = 0; ks < 8; ++ks) st = __builtin_amdgcn_mfma_f32_32x32x16_bf16(tr_frag(Xde, 16 * ks, hd * 64 + pt * 32, lane), tr_frag(Bm, 16 * ks, j * 32, lane), st, 0, 0, 0);
            float* so = F_ST + ((size_t)((b * 64 + cc) * 4 + 2 * g + hd) * 64) * 128;
#pragma unroll
            for (int r = 0; r < 16; ++r) { const int pp = pt * 32 + (r & 3) + 8 * (r >> 2) + 4 * hh; so[(size_t)pp * 128 + j * 32 + c] = st[r]; }
        }
    }
    __syncthreads();
}
__device__ __forceinline__ void ssd_scan_item(Frame& F, int gws) {
    const int e = gws * 64 + opq(F.lane), bh = e >> 13, pn = e & 8191, b = bh >> 2, h = bh & 3;
    const float* st = F_ST + ((size_t)(b * 64 * 4 + h) * 8192) + pn; bf16* pv = F_PREV + ((size_t)(b * 64 * 4 + h) * 8192) + pn;
    const float* ae = F_ACS + ((size_t)b * SEQ + 127) * 4 + h;
    float carry = 0.f;
    for (int c0 = 0; c0 < 64; c0 += 16) {
        float sv[16], dv[16];
#pragma unroll
        for (int i = 0; i < 16; ++i) { sv[i] = st[(size_t)(c0 + i) * 4 * 8192]; dv[i] = ae[(size_t)(c0 + i) * 128 * 4]; }
#pragma unroll
        for (int i = 0; i < 16; ++i) { pv[(size_t)(c0 + i) * 4 * 8192] = (bf16)f2bf(carry); carry = carry * __expf(dv[i]) + sv[i]; }
    }
}
__device__ __forceinline__ void ssd_yoff_item(Frame& F, int l, int it) {
    const int lane = opq(F.lane), c = lane & 31, hh = lane >> 5;
    const int lb = it & 3, h = (it >> 2) & 3, cc = (it >> 4) & 63, b = it >> 10, g = h >> 1;
    const int m0 = b * SEQ + cc * 128 + lb * 32;
    const bf16* A = F_CS + (size_t)(m0 + c) * 256 + g * 128 + 8 * hh;
    const bf16* Bt = F_PREV + ((size_t)((b * 64 + cc) * 4 + h) * 8192) + (size_t)c * 128 + 8 * hh;
    f32x16 a0, a1;
#pragma unroll
    for (int r = 0; r < 16; ++r) { a0[r] = 0.f; a1[r] = 0.f; }
#pragma unroll
    for (int ks = 0; ks < 8; ++ks) { const bf16x8 af = *(const bf16x8*)(A + ks * 16);
        a0 = __builtin_amdgcn_mfma_f32_32x32x16_bf16(af, *(const bf16x8*)(Bt + ks * 16), a0, 0, 0, 0);
        a1 = __builtin_amdgcn_mfma_f32_32x32x16_bf16(af, *(const bf16x8*)(Bt + 32 * 128 + ks * 16), a1, 0, 0, 0); }
    const float Dk = FIN(I_SSDD)[l * 4 + h];
#pragma unroll
    for (int r = 0; r < 16; ++r) { const size_t m = (size_t)(m0 + (r & 3) + 8 * (r >> 2) + 4 * hh); const float ea = __expf(F_ACS[m * 4 + h]);
#pragma unroll
        for (int pt = 0; pt < 2; ++pt) { const int ch = h * 64 + pt * 32 + c; const float acc = pt ? a1[r] : a0[r];
            const float y = (F_YC[m * 256 + ch] + acc * ea + Dk * bf2f(F_XS[m * 256 + ch])) * siluf(bf2f(F_PROJ[m * NPP + PC_Z + ch]));
            F_YC[m * 256 + ch] = y; } }
}

__device__ __forceinline__ void x3_post(Frame& F, int l) {
    const int gw = F.vcu * NWAVES + F.wave, NGW = F.G * NWAVES, lane = opq(F.lane);
    LAS float* gs = (LAS float*)(F.lds + RING_OFF + F.wave * 16384);
    const float* bnw = FIN(I_BNW) + l * D; const float* gwt = FIN(I_GLUW) + (size_t)l * 256 * 256; const float* gbias = FIN(I_GLUB) + l * 256;
    for (int blk = gw; blk < M / 8; blk += NGW) {
        const int m0 = blk * 8;
        for (int tok = 0; tok < 8; ++tok) {
            const int m = m0 + tok; float y[4], ss = 0.f;
#pragma unroll
            for (int j = 0; j < 4; ++j) { y[j] = F_YC[(size_t)m * 256 + lane + 64 * j]; ss += y[j] * y[j]; }
            const float r = 1.0f / sqrtf(wave_sum(ss) * (1.0f / 256.f) + EPS);
#pragma unroll
            for (int j = 0; j < 4; ++j) { const int c = lane + 64 * j; F_GROUPS[(size_t)m * D + 512 + c] = (bf16)f2bf(y[j] * r * bnw[512 + c]); }
#pragma unroll
            for (int j = 0; j < 4; ++j) gs[tok * 256 + lane + 64 * j] = gelu_tanh(F_YS[(size_t)m * 256 + lane + 64 * j]);
        }
        LDS_WAIT(); asm volatile("" ::: "memory");
        float acc[8][4];
#pragma unroll
        for (int tok = 0; tok < 8; ++tok)
#pragma unroll
            for (int j = 0; j < 4; ++j) acc[tok][j] = 0.f;
        for (int c = 0; c < 256; ++c) {
            float w[4];
#pragma unroll
            for (int j = 0; j < 4; ++j) w[j] = gwt[(size_t)c * 256 + lane + 64 * j];
#pragma unroll
            for (int tok = 0; tok < 8; ++tok) { const float gv = gs[tok * 256 + c];
#pragma unroll
                for (int j = 0; j < 4; ++j) acc[tok][j] += gv * w[j]; }
        }
#pragma unroll
        for (int tok = 0; tok < 8; ++tok) {
            const int m = m0 + tok; float y[4], ss = 0.f;
#pragma unroll
            for (int j = 0; j < 4; ++j) { const float gv = gs[tok * 256 + lane + 64 * j]; y[j] = gv * sigmf(acc[tok][j] + gbias[lane + 64 * j]); ss += y[j] * y[j]; }
            const float r = 1.0f / sqrtf(wave_sum(ss) * (1.0f / 256.f) + EPS);
#pragma unroll
            for (int j = 0; j < 4; ++j) { const int c = lane + 64 * j; F_GROUPS[(size_t)m * D + 768 + c] = (bf16)f2bf(y[j] * r * bnw[768 + c]); }
        }
        LDS_WAIT(); asm volatile("" ::: "memory");
    }
}

#ifndef PROBE_DBL
#define PROBE_DBL 0
#endif
template <int l> __device__ __forceinline__ void layer_body(Frame& F, const XcdBarrier& bar) {
#define GRID_BAR() do { xcd_barrier(bar); if (PROBE_DBL == 11) xcd_barrier(bar); } while (0)
        const float* hsrc = (l == 0) ? FIN(I_X) : F_H;
    norm_phase(F, hsrc, FIN(I_NMIX) + l * D, l, 0, 1, F_UV, true);
    if (PROBE_DBL == 1) norm_phase(F, hsrc, FIN(I_NMIX) + l * D, l, 0, 1, F_UV, true);
    GRID_BAR();
    { pg8::Gemm g{F_UV, F_WinT + (size_t)l * NPROJ * D, M, 2048, D}; pg8::StaticOrder S; S.init(M, 2048, F.G, (int)blockIdx.x);
      pg8::EpiBf16<0> E{F_PROJ, NPP};
      pg8::gemm_phase<pg8::EpiBf16<0>, pg8::StaticOrder, true, true>(F.lds + RING_OFF, g, S, E); }
    { pg8::Gemm g{F_UV, F_WinT + (size_t)l * NPROJ * D + (size_t)2048 * D, M, 256, D}; pg8::StaticOrder S; S.init(M, 256, F.G, (int)blockIdx.x);
      pg8::EpiCompact16 E{F_US5, M};
      pg8::gemm_phase<pg8::EpiCompact16, pg8::StaticOrder, true, true>(F.lds + RING_OFF, g, S, E); }
    if (PROBE_DBL == 2) {
    { pg8::Gemm g{F_UV, F_WinT + (size_t)l * NPROJ * D, M, 2048, D}; pg8::StaticOrder S; S.init(M, 2048, F.G, (int)blockIdx.x);
      pg8::EpiBf16<0> E{F_PROJ, NPP};
      pg8::gemm_phase<pg8::EpiBf16<0>, pg8::StaticOrder, true, true>(F.lds + RING_OFF, g, S, E); }
    { pg8::Gemm g{F_UV, F_WinT + (size_t)l * NPROJ * D + (size_t)2048 * D, M, 256, D}; pg8::StaticOrder S; S.init(M, 256, F.G, (int)blockIdx.x);
      pg8::EpiCompact16 E{F_US5, M};
      pg8::gemm_phase<pg8::EpiCompact16, pg8::StaticOrder, true, true>(F.lds + RING_OFF, g, S, E); }
    }
    GRID_BAR();
    for (int u = F.vcu; u < 256; u += F.G) ssd_chunk_unit(F, l, u >> 7, (u >> 1) & 63, u & 1);
    if ((F.wave & 3) == 0) { for (int it = F.vcu * 2 + (F.wave >> 2); it < 512; it += F.G * 2) s5_send_item(F, l, it); }
    x1_pool_sconv(F, l);
    if (PROBE_DBL == 3 || PROBE_DBL == 12) { for (int u = F.vcu; u < 256; u += F.G) ssd_chunk_unit(F, l, u >> 7, (u >> 1) & 63, u & 1); }
    if (PROBE_DBL == 3 || PROBE_DBL == 13) { if ((F.wave & 3) == 0) { for (int it = F.vcu * 2 + (F.wave >> 2); it < 512; it += F.G * 2) s5_send_item(F, l, it); } }
    if (PROBE_DBL == 3 || PROBE_DBL == 14) x1_pool_sconv(F, l);
    GRID_BAR();
    s5_xb_item(F, l, F.vcu >> 7, (F.vcu >> 3) & 15, (F.vcu >> 1) & 3, F.vcu & 1);
    if (F.wave < 4) ssd_scan_item(F, F.vcu * 4 + F.wave);
    if (PROBE_DBL == 4 || PROBE_DBL == 15) s5_xb_item(F, l, F.vcu >> 7, (F.vcu >> 3) & 15, (F.vcu >> 1) & 3, F.vcu & 1);
    if (PROBE_DBL == 4 || PROBE_DBL == 16) { if (F.wave < 4) ssd_scan_item(F, F.vcu * 4 + F.wave); }
    GRID_BAR();
    for (int it = F.vcu * NWAVES + F.wave; it < 2048; it += F.G * NWAVES) ssd_yoff_item(F, l, it);
    if (PROBE_DBL == 5) { GRID_BAR(); for (int it = F.vcu * NWAVES + F.wave; it < 2048; it += F.G * NWAVES) ssd_yoff_item(F, l, it); }
    GRID_BAR();
    x3_post(F, l);
    if (PROBE_DBL == 6) x3_post(F, l);
    GRID_BAR();
    { pg8::Gemm g{F_GROUPS, F_WoutT + (size_t)l * D * D, M, D, D}; pg8::StaticOrder S; S.init(M, D, F.G, (int)blockIdx.x);
      pg8::EpiResGate E{hsrc, F_H, D, F_MODP + (size_t)l * 2 * MOD + 2 * D, FIN(I_ADAB) + (size_t)l * MOD + 2 * D, 2 * 2 * MOD, MOD, SEQ};
      pg8::gemm_phase<pg8::EpiResGate, pg8::StaticOrder, true, true>(F.lds + RING_OFF, g, S, E); }
    GRID_BAR();
    norm_phase(F, F_H, FIN(I_NMLP) + l * D, l, 3, 4, F_UV, false);
    if (PROBE_DBL == 7) norm_phase(F, F_H, FIN(I_NMLP) + l * D, l, 3, 4, F_UV, false);
    GRID_BAR();
    { pg8::Gemm g{F_UV, F_W1T + (size_t)l * FF * D, M, FF, D}; pg8::StaticOrder S; S.init(M, FF, F.G, (int)blockIdx.x);
      pg8::EpiBf16<2> E{F_HID, FF};
      pg8::gemm_phase<pg8::EpiBf16<2>, pg8::StaticOrder, true, true>(F.lds + RING_OFF, g, S, E); }
    if (PROBE_DBL == 8)
    { pg8::Gemm g{F_UV, F_W1T + (size_t)l * FF * D, M, FF, D}; pg8::StaticOrder S; S.init(M, FF, F.G, (int)blockIdx.x);
      pg8::EpiBf16<2> E{F_HID, FF};
      pg8::gemm_phase<pg8::EpiBf16<2>, pg8::StaticOrder, true, true>(F.lds + RING_OFF, g, S, E); }
    GRID_BAR();
    { pg8::Gemm g{F_HID, F_W2T + (size_t)l * D * FF, M, D, FF}; pg8::StaticOrder S; S.init(M, D, F.G, (int)blockIdx.x);
      pg8::EpiResGate E{F_H, F_H, D, F_MODP + (size_t)l * 2 * MOD + 5 * D, FIN(I_ADAB) + (size_t)l * MOD + 5 * D, 2 * 2 * MOD, MOD, SEQ};
      pg8::gemm_phase<pg8::EpiResGate, pg8::StaticOrder, true, true>(F.lds + RING_OFF, g, S, E); }
    GRID_BAR();
}

struct Args { const float* in[N_IN]; float* out; unsigned char* ws; };
__global__ void __launch_bounds__(NWAVES * 64, 2) mk_fwd(Args args_unused) {
    extern __shared__ __attribute__((aligned(16))) unsigned char lds[];
    Frame F;
    F.lds = (LAS unsigned char*)lds;
    F.MISC = (volatile LAS unsigned*)(F.lds + MISC_OFF);
    F.tid = threadIdx.x; F.lane = F.tid & 63; F.wave = __builtin_amdgcn_readfirstlane(F.tid >> 6);
    F.G = gridDim.x; { const int bx = blockIdx.x; F.vcu = (F.G % 8 == 0) ? (bx % 8) * (F.G / 8) + bx / 8 : bx; }
    F.karg = (const __attribute__((address_space(4))) unsigned char*)__builtin_amdgcn_kernarg_segment_ptr();
    F.ws = *(unsigned char* const __attribute__((address_space(4)))*)(F.karg + 8 * (N_IN + 1));
    F.ctl = (gu32*)(F.ws + WS_CTL);
    for (int u = F.tid; u < (LDS_BYTES - LDSCTL_OFF) / 4; u += NWAVES * 64) ((LAS unsigned*)(F.lds + LDSCTL_OFF))[u] = 0u;
    __syncthreads();
    XcdBarrier bar = xcd_barrier_post((unsigned*)(F.ctl + CW_BAR), F.MISC + 8);

    p0_prologue(F);
    if (PROBE_DBL == 9) p0_prologue(F);
    GRID_BAR();
    layer_body<0>(F, bar);
    layer_body<1>(F, bar);
    final_norm_phase(F);
}

extern "C" void kernel_launch(void* const* d_in, const int* in_sizes, int n_in, void* d_out, int out_size, void* d_ws, size_t ws_size, hipStream_t stream) {
    static int grid = 0;
    if (grid == 0) {
        if (n_in != N_IN || in_sizes[0] != M * D || out_size != M * D || ws_size < WS_END) { fprintf(stderr, "kernel_launch: unexpected shapes (n_in %d, in0 %d, out %d, ws %zu); nothing launched\n", n_in, n_in > 0 ? in_sizes[0] : -1, out_size, ws_size); grid = -1; return; }
        int dev = 0, cus = 0, per_cu = 0;
        if (hipGetDevice(&dev) != hipSuccess || hipDeviceGetAttribute(&cus, hipDeviceAttributeMultiprocessorCount, dev) != hipSuccess) { grid = -1; return; }
        if (hipFuncSetAttribute((const void*)mk_fwd, hipFuncAttributeMaxDynamicSharedMemorySize, LDS_BYTES) != hipSuccess) { fprintf(stderr, "kernel_launch: hipFuncSetAttribute failed\n"); grid = -1; return; }
        if (hipOccupancyMaxActiveBlocksPerMultiprocessor(&per_cu, (const void*)mk_fwd, NWAVES * 64, LDS_BYTES) != hipSuccess || per_cu < 1) fprintf(stderr, "kernel_launch: occupancy query reports %d\n", per_cu);
        (void)hipGetLastError();
        grid = cus;
    }
    if (grid < 0) return;
    if (hipMemsetAsync((char*)d_ws + WS_CTL, 0, CTL_ZERO_BYTES, stream) != hipSuccess) return;
    Args a{};
    for (int i = 0; i < N_IN; ++i) a.in[i] = (const float*)d_in[i];
    a.out = (float*)d_out; a.ws = (unsigned char*)d_ws;
    hipLaunchKernelGGL(mk_fwd, dim3(grid), dim3(NWAVES * 64), LDS_BYTES, stream, a);
}
```

```cpp
#include <hip/hip_runtime.h>
#include <cstdio>
#include <cstdint>
#include <cmath>
namespace pg8 {
#define PG8_LAS __attribute__((address_space(3)))
typedef unsigned short bf16_t;
typedef short bf16x8 __attribute__((ext_vector_type(8)));
typedef float f32x4 __attribute__((ext_vector_type(4)));
typedef unsigned u32x4 __attribute__((ext_vector_type(4)));
constexpr int BM = 256, BK = 64, HALF = 128, HTB = HALF * BK * 2  , STAGE_BYTES = 8 * HTB, NXCD = 8, WGM = 8;

__host__ __device__ __forceinline__ int lds_byte(int r, int c) { const int st = (r >> 4) * 2 + (c >> 5), rr = r & 15, cc = c & 31, ob = rr * 64 + cc * 2; return st * 1024 + (ob ^ (((ob >> 9) & 1) << 5)); }
__host__ __device__ __forceinline__ void stage_rc(int b, int& R, int& C) { const int st = b / 1024, sb = b % 1024, swz = sb ^ (((sb >> 9) & 1) << 5); R = (st >> 1) * 16 + swz / 64; C = (st & 1) * 32 + (swz % 64) / 2; }
__host__ __device__ __forceinline__ int perm32(int rho) { const int n = rho >> 4, i = rho & 15; return 8 * (i >> 2) + 4 * n + (i & 3); }

struct Unit { int pm, pn; };
struct Gemm { const bf16_t* A; const bf16_t* Bt; int M, N, K; };

struct StaticOrder {
    int nM, nN, nwg, G, c;
    __host__ __device__ void init(int M, int N, int G_, int c_) { nM = M / BM; nN = N / BM; nwg = nM * nN; G = G_; c = c_; }
    __host__ __device__ bool next(int i, Unit& u) const {
        const long L = (long)i * G + c; if (L >= nwg) return false;
        int wgid = (int)L; { const int q = nwg / NXCD, r = nwg % NXCD, xcd = wgid % NXCD, off = wgid / NXCD; wgid = (xcd < r ? xcd * (q + 1) : r * (q + 1) + (xcd - r) * q) + off; }
        const int nig = WGM * nN, gid = wgid / nig, fm = gid * WGM, gsz = (nM - fm) < WGM ? (nM - fm) : WGM;
        u.pm = fm + ((wgid % nig) % gsz); u.pn = (wgid % nig) / gsz; return true;
    }
    __device__ __forceinline__ void a_ready(const Unit&) const {}
    __device__ __forceinline__ void done(const Unit&) const {}
};


__device__ __forceinline__ unsigned cvt_pk_bf16(float lo, float hi) { unsigned r; asm volatile("v_cvt_pk_bf16_f32 %0, %1, %2" : "=v"(r) : "v"(lo), "v"(hi)); return r; }

template <int ACT> struct EpiBf16 {
    static constexpr bool PERM = true, AFTER_DRAIN = false;
    bf16_t* O; int ldc;
    __device__ __forceinline__ void operator()(const f32x4 (&acc)[2][2][4][2], const Unit& u, int wr, int wc, int fr, int fq) const {
        const int row0 = u.pm * BM + wr * 64 + fr; const int col0 = u.pn * BM + wc * 32 + 8 * fq;
#pragma unroll
        for (int ai = 0; ai < 2; ++ai)
#pragma unroll
            for (int m = 0; m < 4; ++m) { bf16_t* rowp = O + (size_t)(row0 + ai * HALF + m * 16) * ldc + col0;
#pragma unroll
                for (int bj = 0; bj < 2; ++bj) { f32x4 v0 = acc[ai][bj][m][0], v1 = acc[ai][bj][m][1];
                    if (ACT == 2) {
#pragma unroll
                        for (int e = 0; e < 4; ++e) { const float a = v0[e] > 0.f ? v0[e] : 0.f, b = v1[e] > 0.f ? v1[e] : 0.f; v0[e] = a * a; v1[e] = b * b; } }
                    u32x4 w; w.x = cvt_pk_bf16(v0[0], v0[1]); w.y = cvt_pk_bf16(v0[2], v0[3]); w.z = cvt_pk_bf16(v1[0], v1[1]); w.w = cvt_pk_bf16(v1[2], v1[3]);
                    *(u32x4*)(rowp + bj * HALF) = w; } }
    }
};
struct EpiCompact16 {
    static constexpr bool PERM = true, AFTER_DRAIN = false;
    bf16_t* O; int M2;
    __device__ __forceinline__ void operator()(const f32x4 (&acc)[2][2][4][2], const Unit& u, int wr, int wc, int fr, int fq) const {
        const int row0 = u.pm * BM + wr * 64 + fr; const int cl = wc * 32 + 8 * fq;
        bf16_t* const base = O + (size_t)(cl >> 4) * M2 * 16 + (cl & 15);
#pragma unroll
        for (int ai = 0; ai < 2; ++ai)
#pragma unroll
            for (int m = 0; m < 4; ++m) { bf16_t* rowp = base + (size_t)(row0 + ai * HALF + m * 16) * 16;
#pragma unroll
                for (int bj = 0; bj < 2; ++bj) { const f32x4 v0 = acc[ai][bj][m][0], v1 = acc[ai][bj][m][1];
                    u32x4 w; w.x = cvt_pk_bf16(v0[0], v0[1]); w.y = cvt_pk_bf16(v0[2], v0[3]); w.z = cvt_pk_bf16(v1[0], v1[1]); w.w = cvt_pk_bf16(v1[2], v1[3]);
                    *(u32x4*)(rowp + (size_t)bj * 8 * M2 * 16) = w; } }
    }
};

struct EpiResGate {
    static constexpr bool PERM = false, AFTER_DRAIN = false;
    const float* base; float* out; int ldc; const float* gp; const float* gb; int gps, gbs, rows_per_batch;
    __device__ __forceinline__ void operator()(const f32x4 (&acc)[2][2][4][2], const Unit& u, int wr, int wc, int fr, int fq) const {
        const int col0 = u.pn * BM + wc * 32 + 4 * fq; const int b = (u.pm * BM) / rows_per_batch;
        f32x4 gv[2][2];
#pragma unroll
        for (int bj = 0; bj < 2; ++bj)
#pragma unroll
            for (int n = 0; n < 2; ++n) { const int c = col0 + bj * HALF + n * 16; const float* q = gp + (size_t)b * gbs + c;
                gv[bj][n] = *(const f32x4*)(gb + c) + ((*(const f32x4*)(q) + *(const f32x4*)(q + gps)) + (*(const f32x4*)(q + 2 * (size_t)gps) + *(const f32x4*)(q + 3 * (size_t)gps))); }
#pragma unroll
        for (int ai = 0; ai < 2; ++ai)
#pragma unroll
            for (int m = 0; m < 4; ++m) { const size_t off = (size_t)(u.pm * BM + ai * HALF + wr * 64 + m * 16 + fr) * ldc + col0;
#pragma unroll
                for (int bj = 0; bj < 2; ++bj)
#pragma unroll
                    for (int n = 0; n < 2; ++n) { const f32x4 bs = *(const f32x4*)(base + off + bj * HALF + n * 16);
                        *(f32x4*)(out + off + bj * HALF + n * 16) = bs + gv[bj][n] * acc[ai][bj][m][n]; }
                if (m & 1) asm volatile("" ::: "memory"); }
    }
};

template <class Epi, class Sched, bool ALIGN_EPI = false, bool SP2 = false>
__device__ __forceinline__ void gemm_phase(PG8_LAS unsigned char* lds, const Gemm g, const Sched& S, const Epi& E) {
    const int tid = threadIdx.x, wid = __builtin_amdgcn_readfirstlane(tid >> 6), lane = tid & 63, wr = wid >> 2, wc = wid & 3, fr = lane & 15, fq = lane >> 4;
    const int K = g.K, nt = K / BK;
    unsigned voffA[2], voffB[2];
#pragma unroll
    for (int i = 0; i < 2; ++i) { int R, C; stage_rc(tid * 16 + i * 8192, R, C); const int Rb = Epi::PERM ? ((R & ~31) + perm32(R & 31)) : R;
        voffA[i] = (unsigned)(R * K + C) * 2u; voffB[i] = (unsigned)(Rb * K + C) * 2u; }
    const size_t kstep = (size_t)(BK * 2);
    const size_t hstep = (size_t)HALF * K * 2;
    const size_t tstep = 2 * hstep;
    const unsigned ldsw = (unsigned)wid * 1024u;
    const int aoff = lds_byte(wr * 64 + fr, fq * 8), boff = lds_byte(wc * 32 + fr, fq * 8);
#define PG8_SA(b, h) (((b) * 2 + (h)) * HTB)
#define PG8_SB(b, h) ((4 + (b) * 2 + (h)) * HTB)
#define PG8_STAGE(bufoff, gbase, voff) do { _Pragma("unroll") for (int _i = 0; _i < 2; ++_i) \
        __builtin_amdgcn_global_load_lds((const unsigned*)((const char*)(gbase) + (voff)[_i]), (PG8_LAS unsigned*)(lds + (bufoff) + ldsw + _i * 8192), 16, 0, 0); } while (0)
#define PG8_LDA(dst, b, h) do { _Pragma("unroll") for (int m = 0; m < 4; ++m) _Pragma("unroll") for (int k = 0; k < 2; ++k) dst[m][k] = *(const PG8_LAS bf16x8*)(lds + PG8_SA(b, h) + aoff + m * 2048 + k * 1024); } while (0)
#define PG8_LDB(dst, b, h) do { _Pragma("unroll") for (int n = 0; n < 2; ++n) _Pragma("unroll") for (int k = 0; k < 2; ++k) dst[n][k] = *(const PG8_LAS bf16x8*)(lds + PG8_SB(b, h) + boff + n * 2048 + k * 1024); } while (0)
#define PG8_MMA(ai, bj, At, Bt) do { __builtin_amdgcn_s_setprio(1); _Pragma("unroll") for (int m = 0; m < 4; ++m) _Pragma("unroll") for (int n = 0; n < 2; ++n) _Pragma("unroll") for (int k = 0; k < 2; ++k) \
        acc[ai][bj][m][n] = __builtin_amdgcn_mfma_f32_16x16x32_bf16(Bt[n][k], At[m][k], acc[ai][bj][m][n], 0, 0, 0); __builtin_amdgcn_s_setprio(0); } while (0)
#define PG8_WAIT_V(n) asm volatile("s_waitcnt vmcnt(" #n ")" ::: "memory")
#define PG8_WAIT_L(n) asm volatile("s_waitcnt lgkmcnt(" #n ")" ::: "memory")
#define PG8_BAR __builtin_amdgcn_s_barrier()
#define PG8_SCHED __builtin_amdgcn_sched_barrier(0)
    Unit cur, nxt; int ui = 0;
    if (!S.next(0, cur)) return;
    f32x4 acc[2][2][4][2];
#pragma unroll
    for (int a = 0; a < 2; ++a)
#pragma unroll
        for (int b = 0; b < 2; ++b)
#pragma unroll
            for (int m = 0; m < 4; ++m)
#pragma unroll
                for (int n = 0; n < 2; ++n) acc[a][b][m][n] = (f32x4){0.f, 0.f, 0.f, 0.f};
    bf16x8 At[4][2], B0[2][2], B1[2][2];
    const char* cA = (const char*)g.A + (size_t)cur.pm * tstep; const char* cB = (const char*)g.Bt + (size_t)cur.pn * tstep;
    S.a_ready(cur);
    if constexpr (SP2) {
        PG8_STAGE(PG8_SB(0, 0), cB, voffB); PG8_STAGE(PG8_SB(0, 1), cB + hstep, voffB); PG8_STAGE(PG8_SA(0, 0), cA, voffA); PG8_STAGE(PG8_SA(0, 1), cA + hstep, voffA);
        if (wr == 1) PG8_BAR;
        PG8_WAIT_V(2); PG8_BAR;
        PG8_STAGE(PG8_SB(1, 0), cB + kstep, voffB); PG8_STAGE(PG8_SA(1, 0), cA + kstep, voffA); PG8_STAGE(PG8_SB(1, 1), cB + hstep + kstep, voffB);
        PG8_WAIT_V(6); PG8_BAR;
    } else {
        PG8_STAGE(PG8_SB(0, 0), cB, voffB); PG8_STAGE(PG8_SA(0, 0), cA, voffA); PG8_STAGE(PG8_SB(0, 1), cB + hstep, voffB); PG8_STAGE(PG8_SA(0, 1), cA + hstep, voffA);
        if (wr == 1) PG8_BAR;
        PG8_WAIT_V(4); PG8_BAR;
        PG8_STAGE(PG8_SB(1, 0), cB + kstep, voffB); PG8_STAGE(PG8_SA(1, 0), cA + kstep, voffA); PG8_STAGE(PG8_SB(1, 1), cB + hstep + kstep, voffB);
        PG8_WAIT_V(6); PG8_BAR;
    }
    for (;;) {
        const bool has_next = S.next(ui + 1, nxt);
        const char* nA = has_next ? (const char*)g.A + (size_t)nxt.pm * tstep : cA; const char* nB = has_next ? (const char*)g.Bt + (size_t)nxt.pn * tstep : cB;
        for (int t = 0; t < nt; t += 2) {
            const bool last = (t == nt - 2);
            const char* a1 = cA + (size_t)(t + 1) * kstep;
            const char* a2 = last ? nA : cA + (size_t)(t + 2) * kstep; const char* b2 = last ? nB : cB + (size_t)(t + 2) * kstep;
            const char* a3 = a2 + kstep; const char* b3 = b2 + kstep;
            if (last && has_next) S.a_ready(nxt);
            if constexpr (SP2) {
            PG8_LDB(B0, 0, 0); PG8_LDB(B1, 0, 1); PG8_SCHED; PG8_LDA(At, 0, 0); PG8_STAGE(PG8_SA(1, 1), a1 + hstep, voffA);
            PG8_WAIT_V(8); PG8_WAIT_L(0); PG8_BAR; PG8_MMA(0, 0, At, B0); PG8_MMA(0, 1, At, B1); PG8_BAR; PG8_SCHED;
            PG8_LDA(At, 0, 1); PG8_STAGE(PG8_SB(0, 0), b2, voffB); PG8_STAGE(PG8_SB(0, 1), b2 + hstep, voffB); PG8_STAGE(PG8_SA(0, 0), a2, voffA);
            PG8_WAIT_V(8); PG8_WAIT_L(0); PG8_BAR; PG8_MMA(1, 0, At, B0); PG8_MMA(1, 1, At, B1); PG8_BAR; PG8_SCHED;
            PG8_LDB(B0, 1, 0); PG8_LDB(B1, 1, 1); PG8_SCHED; PG8_LDA(At, 1, 0); PG8_STAGE(PG8_SA(0, 1), a2 + hstep, voffA);
            PG8_WAIT_V(8); PG8_WAIT_L(0); PG8_BAR; PG8_MMA(0, 0, At, B0); PG8_MMA(0, 1, At, B1); PG8_BAR; PG8_SCHED;
            PG8_LDA(At, 1, 1); PG8_STAGE(PG8_SB(1, 0), b3, voffB); PG8_STAGE(PG8_SB(1, 1), b3 + hstep, voffB); PG8_STAGE(PG8_SA(1, 0), a3, voffA);
            PG8_WAIT_V(8); PG8_WAIT_L(0); PG8_BAR; PG8_MMA(1, 0, At, B0); PG8_MMA(1, 1, At, B1); PG8_BAR; PG8_SCHED;
            } else {
            PG8_LDB(B0, 0, 0); PG8_SCHED; PG8_LDA(At, 0, 0); PG8_STAGE(PG8_SA(1, 1), a1 + hstep, voffA);
            PG8_WAIT_L(8); PG8_BAR; PG8_WAIT_L(0); PG8_MMA(0, 0, At, B0); PG8_BAR; PG8_SCHED;
            PG8_LDB(B1, 0, 1); PG8_STAGE(PG8_SB(0, 0), b2, voffB);
            PG8_BAR; PG8_WAIT_L(0); PG8_MMA(0, 1, At, B1); PG8_BAR;
            PG8_LDA(At, 0, 1); PG8_STAGE(PG8_SA(0, 0), a2, voffA);
            PG8_BAR; PG8_WAIT_L(0); PG8_MMA(1, 0, At, B0); PG8_BAR; PG8_SCHED;
            PG8_STAGE(PG8_SB(0, 1), b2 + hstep, voffB);
            PG8_WAIT_V(6); PG8_BAR; PG8_MMA(1, 1, At, B1); PG8_BAR;
            PG8_LDB(B0, 1, 0); PG8_SCHED; PG8_LDA(At, 1, 0); PG8_STAGE(PG8_SA(0, 1), a2 + hstep, voffA);
            PG8_WAIT_L(8); PG8_BAR; PG8_WAIT_L(0); PG8_MMA(0, 0, At, B0); PG8_BAR; PG8_SCHED;
            PG8_LDB(B1, 1, 1); PG8_STAGE(PG8_SB(1, 0), b3, voffB);
            PG8_BAR; PG8_WAIT_L(0); PG8_MMA(0, 1, At, B1); PG8_BAR;
            PG8_LDA(At, 1, 1); PG8_STAGE(PG8_SA(1, 0), a3, voffA);
            PG8_BAR; PG8_WAIT_L(0); PG8_MMA(1, 0, At, B0); PG8_BAR; PG8_SCHED;
            PG8_STAGE(PG8_SB(1, 1), b3 + hstep, voffB);
            PG8_WAIT_V(6); PG8_BAR; PG8_MMA(1, 1, At, B1); PG8_BAR;
            }
        }
        if constexpr (ALIGN_EPI) { if (wr == 0) PG8_BAR; }
        if constexpr (!Epi::AFTER_DRAIN) { E(acc, cur, wr, wc, fr, fq); S.done(cur); }
        if (!has_next) break;
#pragma unroll
        for (int a = 0; a < 2; ++a)
#pragma unroll
            for (int b = 0; b < 2; ++b)
#pragma unroll
                for (int m = 0; m < 4; ++m)
#pragma unroll
                    for (int n = 0; n < 2; ++n) acc[a][b][m][n] = (f32x4){0.f, 0.f, 0.f, 0.f};
        cur = nxt; cA = nA; cB = nB; ++ui;
        if constexpr (ALIGN_EPI) { if (wr == 1) PG8_BAR; }
    }
    PG8_WAIT_V(0);
    if constexpr (!ALIGN_EPI) { if (wr == 0) PG8_BAR; }
    PG8_BAR;
    if constexpr (Epi::AFTER_DRAIN) { E.fused(acc, cur, wr, wc, fr, fq, lds, wid, lane); S.done(cur); }
#undef PG8_SA
#undef PG8_SB
#undef PG8_STAGE
#undef PG8_LDA
#undef PG8_LDB
#undef PG8_MMA
#undef PG8_WAIT_V
#undef PG8_WAIT_L
#undef PG8_BAR
#undef PG8_SCHED
}
}

constexpr int NWAVES = 8;
constexpr int S5L = 64, NCHR = 256  ;
constexpr int BATCH = 2, SEQ = 8192, D = 1024, M = BATCH * SEQ, DEPTH = 2;
constexpr int NPROJ_SRC = 2308, NPROJ = 2304, NPP = 2048  , FF = 4096, MOD = 6 * D;
constexpr float EPS = 1e-6f;
constexpr int PC_POOL = 0, PC_GB = 256, PC_GC = 512, PC_H = 768, PC_Z = 1024, PC_X = 1280, PC_B = 1536, PC_C = 1792, PC_S5 = 2048;
enum { I_X = 0, I_C, I_NMIX, I_NMLP, I_ADAW, I_ADAB, I_WIN, I_POOLW, I_POOLS, I_SCONVW, I_SSDCW, I_SSDCB, I_DTB, I_ALOG, I_SSDD, I_S5ARE, I_S5AIM, I_S5LS, I_S5BRE, I_S5BIM,
       I_S5CRE, I_S5CIM, I_S5D, I_GLUW, I_GLUB, I_BNW, I_WOUT, I_W1, I_W2, I_FNW, N_IN };

constexpr size_t MiB = 1u << 20;
constexpr size_t WS_CTL = 0, CTL_ZERO_BYTES = 1 * MiB;
constexpr size_t WS_WIN = 1 * MiB;
constexpr size_t WS_WOUT = 10 * MiB;
constexpr size_t WS_W1 = 14 * MiB;
constexpr size_t WS_W2 = 30 * MiB;
constexpr size_t WS_UV = 46 * MiB;
constexpr size_t WS_ST = WS_UV;
constexpr size_t WS_PREV = WS_UV + 16 * MiB;
constexpr size_t WS_SEND = WS_UV + 24 * MiB;
constexpr size_t WS_ACS = WS_UV + 26 * MiB;
constexpr size_t WS_PROJ = 78 * MiB;
constexpr size_t WS_GROUPS = 142 * MiB;
constexpr size_t WS_YC = 174 * MiB;
constexpr size_t WS_YS = 190 * MiB;
constexpr size_t WS_HID = 78 * MiB;
constexpr size_t WS_MODP = 206 * MiB;
constexpr size_t WS_DT = 207 * MiB;
constexpr size_t WS_WDT = 207 * MiB + 512 * 1024;
constexpr size_t WS_PWT = 207 * MiB + 576 * 1024;
constexpr size_t WS_GWT = 207 * MiB + 640 * 1024;
constexpr size_t WS_PT = 208 * MiB;
constexpr size_t WS_QT = 216 * MiB;
constexpr size_t WS_KT = 224 * MiB;
constexpr size_t WS_US5 = 225 * MiB;
constexpr size_t WS_XS = 233 * MiB;
constexpr size_t WS_CS = 241 * MiB;
constexpr size_t WS_END = 249 * MiB;
constexpr int CW_BAR = 4096;

constexpr int RING_OFF = 0, RING_BYTES = 131072;
constexpr int LDS_BYTES = 147456;
constexpr int LDSCTL_OFF = LDS_BYTES - 512, MISC_OFF = LDSCTL_OFF + 320;
#define GAS __attribute__((address_space(1)))
#define LAS __attribute__((address_space(3)))
typedef unsigned short bf16;
typedef unsigned v4u __attribute__((ext_vector_type(4)));
typedef float f32x4 __attribute__((ext_vector_type(4)));
typedef short bf16x8 __attribute__((ext_vector_type(8)));
typedef GAS unsigned gu32;
typedef GAS unsigned long long gu64;
#define RLX_AGENT __ATOMIC_RELAXED, __HIP_MEMORY_SCOPE_AGENT
#define LDS_WAIT() asm volatile("s_waitcnt lgkmcnt(0)" ::: "memory")
#define VM_WAIT() asm volatile("s_waitcnt vmcnt(0)" ::: "memory")
__device__ __forceinline__ unsigned long long rt() { return __builtin_amdgcn_s_memrealtime(); }
__device__ __forceinline__ unsigned f2bf(float f) { unsigned u = __builtin_bit_cast(unsigned, f); return (u + 0x7fffu + ((u >> 16) & 1u)) >> 16; }
__device__ __forceinline__ unsigned pk2(float lo, float hi) { return f2bf(lo) | (f2bf(hi) << 16); }

#define XB_TMO      128
#define XB_XCNT(j)  (256  + 64 * (j))
#define XB_XSUB(j)  (1280 + 64 * (j))
#define XB_XGEN(j)  (2304 + 64 * (j))
#define XB_TOP      3328
#define XB_TOPGEN   3392
#define XCD_BAR_WORDS 3456
#define XB_SPIN_CAP (1u << 18)

__device__ __forceinline__ unsigned xb_ld(unsigned* p)              { return __hip_atomic_load(p, __ATOMIC_RELAXED, __HIP_MEMORY_SCOPE_AGENT); }
__device__ __forceinline__ unsigned xb_add(unsigned* p, unsigned v) { return __hip_atomic_fetch_add(p, v, __ATOMIC_RELAXED, __HIP_MEMORY_SCOPE_AGENT); }
__device__ __forceinline__ unsigned xb_xcc_id() { return (unsigned)__builtin_amdgcn_s_getreg((3 << 11) | 20) & 0xFu; }
#define XB_SPIN(cond, bar) do { unsigned _sp = 0; while (cond) { __builtin_amdgcn_s_sleep(1); \
    if ((++_sp & 255u) == 0u) { if (xb_ld(&(bar)[XB_TMO])) break; if (_sp > XB_SPIN_CAP) { atomicAdd(&(bar)[XB_TMO], 1u); break; } } } } while (0)

struct XcdBarrier {
    unsigned* bar; unsigned x;
    volatile LAS unsigned* st;
};

__device__ __forceinline__ XcdBarrier xcd_barrier_post(unsigned* bar, volatile LAS unsigned* st) {
    XcdBarrier b; b.bar = bar; b.x = xb_xcc_id(); b.st = st;
    if (threadIdx.x == 0) (void)xb_add(&bar[XB_XCNT(b.x)], 1u);
    return b;
}
__device__ __forceinline__ void xcd_barrier_complete(unsigned* bar, unsigned x, unsigned& nloc, unsigned& nx) {
    const unsigned G = gridDim.x * gridDim.y * gridDim.z;
    unsigned sum, cnt, mine, sp = 0u;
    for (;;) {
        sum = 0u; cnt = 0u; mine = 0u;
#pragma unroll
        for (unsigned j = 0; j < 16; ++j) { const unsigned c = xb_ld(&bar[XB_XCNT(j)]); sum += c; cnt += (c > 0u) ? 1u : 0u; mine = (j == x) ? c : mine; }
        if (sum == G) break;
        __builtin_amdgcn_s_sleep(1);
        if ((++sp & 255u) == 0u) { if (xb_ld(&bar[XB_TMO])) break; if (sp > XB_SPIN_CAP) { atomicAdd(&bar[XB_TMO], 1u); break; } }
    }
    nloc = mine > 0u ? mine : 1u; nx = cnt > 0u ? cnt : 1u;
}

__device__ __forceinline__ void xcd_barrier(const XcdBarrier& b) {
    asm volatile("s_waitcnt vmcnt(0)" ::: "memory");
    __syncthreads();
    if (threadIdx.x == 0) {
        unsigned* bar = b.bar; asm volatile("" : "+s"(bar));
        __builtin_amdgcn_s_waitcnt(0);
        unsigned nloc = b.st[0], nx = b.st[1];
        if (nloc == 0u) { xcd_barrier_complete(bar, b.x, nloc, nx); b.st[0] = nloc; b.st[1] = nx; }
        const unsigned old = xb_add(&bar[XB_XSUB(b.x)], 1u);
        const unsigned gen = old / nloc;
        if (old + 1u == (gen + 1u) * nloc) {
            __builtin_amdgcn_fence(__ATOMIC_RELEASE, "agent");
            asm volatile("s_waitcnt vmcnt(0)" ::: "memory");
            const unsigned og = xb_add(&bar[XB_TOP], 1u);
            const unsigned tg = og / nx;
            if (og + 1u == (tg + 1u) * nx) xb_add(&bar[XB_TOPGEN], 1u);
            else XB_SPIN(xb_ld(&bar[XB_TOPGEN]) == tg, bar);
            __builtin_amdgcn_fence(__ATOMIC_ACQUIRE, "agent");
            xb_add(&bar[XB_XGEN(b.x)], 1u);
            asm volatile("s_waitcnt vmcnt(0)" ::: "memory");
        } else {
            XB_SPIN(xb_ld(&bar[XB_XGEN(b.x)]) == gen, bar);
            __builtin_amdgcn_fence(__ATOMIC_ACQUIRE, "agent");
            asm volatile("s_waitcnt vmcnt(0)" ::: "memory");
        }
    }
    __syncthreads();
}

struct Frame {
    LAS unsigned char* lds;
    volatile LAS unsigned* MISC;
    gu32* ctl;
    int tid, lane, wave;
    int vcu, G;
    const __attribute__((address_space(4))) unsigned char* karg;
    unsigned char* ws;
};
#define FIN(i) (*(const float* const __attribute__((address_space(4)))*)(F.karg + 8 * (i)))
#define F_H (*(float* const __attribute__((address_space(4)))*)(F.karg + 8 * N_IN))
#define F_WinT ((bf16*)(F.ws + WS_WIN))
#define F_WoutT ((bf16*)(F.ws + WS_WOUT))
#define F_W1T ((bf16*)(F.ws + WS_W1))
#define F_W2T ((bf16*)(F.ws + WS_W2))
#define F_UV ((bf16*)(F.ws + WS_UV))
#define F_PROJ ((bf16*)(F.ws + WS_PROJ))
#define F_GROUPS ((bf16*)(F.ws + WS_GROUPS))
#define F_HID ((bf16*)(F.ws + WS_HID))
#define F_YC ((float*)(F.ws + WS_YC))
#define F_YS ((float*)(F.ws + WS_YS))
#define F_MODP ((float*)(F.ws + WS_MODP))
#define F_DT ((float*)(F.ws + WS_DT))
#define F_WDT ((float*)(F.ws + WS_WDT))
#define F_PWT ((bf16*)(F.ws + WS_PWT))
#define F_GWT ((bf16*)(F.ws + WS_GWT))
#define F_PT ((bf16*)(F.ws + WS_PT))
#define F_QT ((bf16*)(F.ws + WS_QT))
#define F_KT ((bf16*)(F.ws + WS_KT))
#define F_US5 ((bf16*)(F.ws + WS_US5))
#define F_SEND ((float*)(F.ws + WS_SEND))
#define F_ST ((float*)(F.ws + WS_ST))
#define F_PREV ((bf16*)(F.ws + WS_PREV))
#define F_ACS ((float*)(F.ws + WS_ACS))
#define F_XS ((bf16*)(F.ws + WS_XS))
#define F_CS ((bf16*)(F.ws + WS_CS))

__device__ __forceinline__ float wave_sum(float v) {
#pragma unroll
    for (int o = 1; o < 64; o <<= 1) v += __shfl_xor(v, o);
    return v;
}
__device__ __forceinline__ int opq(int x) { asm volatile("" : "+v"(x)); return x; }
__device__ __forceinline__ float bf2f(bf16 h) { return __uint_as_float(((unsigned)h) << 16); }
__device__ __forceinline__ float siluf(float x) { return x / (1.f + __expf(-x)); }
__device__ __forceinline__ float sigmf(float x) { return 1.f / (1.f + __expf(-x)); }
__device__ __forceinline__ float softplusf(float x) { return x > 20.f ? x : log1pf(__expf(x)); }
__device__ __forceinline__ float gelu_tanh(float x) { const float t = tanhf(0.7978845608028654f * (x + 0.044715f * x * x * x)); return 0.5f * x * (1.f + t); }

__device__ __forceinline__ f32x4 modv4(const Frame& F, int l, int b, int idx, int col) {
    const float* q = F_MODP + ((size_t)l * 2 + b) * MOD + idx * D + col; constexpr size_t PS = (size_t)2 * 2 * MOD;
    return *(const f32x4*)(FIN(I_ADAB) + (size_t)l * MOD + idx * D + col) + ((*(const f32x4*)q + *(const f32x4*)(q + PS)) + (*(const f32x4*)(q + 2 * PS) + *(const f32x4*)(q + 3 * PS)));
}

__device__ __forceinline__ void p0_transpose_item(const float* W, int K, int Nsrc, int nblk, int shift_from, int shift, bf16* WT, LAS float* scr, int item, int lane) {
    const int kb = item / nblk, nb = item % nblk, k0 = 64 * kb, n0 = 32 * nb, n0s = n0 + (n0 >= shift_from ? shift : 0);
#pragma unroll 8
    for (int i = 0; i < 32; ++i) { const int kk = 2 * i + (lane >> 5); scr[kk * 33 + (lane & 31)] = W[(size_t)(k0 + kk) * Nsrc + n0s + (lane & 31)]; }
    LDS_WAIT(); asm volatile("" ::: "memory");
    const int c = lane & 7;
#pragma unroll
    for (int j = 0; j < 4; ++j) { const int n = (lane >> 3) + 8 * j; const LAS float* s = scr + (8 * c) * 33 + n;
        v4u o; o.x = pk2(s[0 * 33], s[1 * 33]); o.y = pk2(s[2 * 33], s[3 * 33]); o.z = pk2(s[4 * 33], s[5 * 33]); o.w = pk2(s[6 * 33], s[7 * 33]);
        *(GAS v4u*)(WT + (size_t)(n0 + n) * K + k0 + 8 * c) = o; }
    LDS_WAIT(); asm volatile("" ::: "memory");
}

__device__ __forceinline__ void p0_prologue(Frame& F) {
    if (F.vcu < 192) {
        const int l = F.vcu / 96, rem = F.vcu % 96, cb = rem / 4, kq = rem % 4;
        const float* W = FIN(I_ADAW) + (size_t)l * D * MOD + cb * 256 + 4 * F.lane; const float* c = FIN(I_C);
        f32x4 a0 = {0.f, 0.f, 0.f, 0.f}, a1 = {0.f, 0.f, 0.f, 0.f};
        const int kbeg = kq * 256 + F.wave * 32;
#pragma unroll 8
        for (int k = kbeg; k < kbeg + 32; ++k) { const f32x4 w = *(const f32x4*)(W + (size_t)k * MOD); const float c0 = siluf(c[k]), c1 = siluf(c[D + k]); a0 += w * c0; a1 += w * c1; }
        LAS f32x4* red = (LAS f32x4*)(F.lds);
        red[(F.wave * 64 + F.lane) * 2 + 0] = a0; red[(F.wave * 64 + F.lane) * 2 + 1] = a1;
        __syncthreads();
        if (F.wave == 0) {
            f32x4 s0 = {0.f, 0.f, 0.f, 0.f}, s1 = {0.f, 0.f, 0.f, 0.f};
#pragma unroll
            for (int w = 0; w < 8; ++w) { s0 += red[(w * 64 + F.lane) * 2 + 0]; s1 += red[(w * 64 + F.lane) * 2 + 1]; }
            float* o = F_MODP + ((size_t)(kq * 2 + l) * 2) * MOD + cb * 256 + 4 * F.lane;
            *(f32x4*)o = s0; *(f32x4*)(o + MOD) = s1;
        }
        __syncthreads();
    }
    LAS float* scr = (LAS float*)(F.lds + RING_OFF + F.wave * 16384);
    const int gw = F.vcu * NWAVES + F.wave, NGW = F.G * NWAVES;
    for (int i = gw * 64 + F.lane; i < DEPTH * 4 * 64 * 64; i += NGW * 64) { const int cc = i & 63, d = (i >> 6) & 63, lgp = i >> 12; F_PWT[i] = (bf16)f2bf(FIN(I_POOLW)[((size_t)lgp * 64 + cc) * 64 + d]); }
    for (int i = gw * 64 + F.lane; i < DEPTH * 256 * 256; i += NGW * 64) { const int cc = i & 255, d = (i >> 8) & 255, ll = i >> 16; F_GWT[i] = (bf16)f2bf(FIN(I_GLUW)[((size_t)ll * 256 + cc) * 256 + d]); }
    for (int idx = gw * 64 + F.lane; idx < DEPTH * 16 * 64 * 64; idx += NGW * 64) {
        const int s = idx & 63, pp = (idx >> 6) & 63, lg = idx >> 12;
        const float are = FIN(I_S5ARE)[lg * 64 + pp], aim = FIN(I_S5AIM)[lg * 64 + pp], step = expf(FIN(I_S5LS)[lg]);
        const float mag = expf(are * step), lr = mag * cosf(aim * step), li = mag * sinf(aim * step);
        const float den = are * are + aim * aim, nr = lr - 1.0f, fre = (nr * are + li * aim) / den, fim = (li * are - nr * aim) / den;
        const float e1 = (float)(63 - s), m1 = expf(e1 * are * step), zr = m1 * cosf(e1 * aim * step), zi = m1 * sinf(e1 * aim * step);
        const float zfr = zr * fre - zi * fim, zfi = zr * fim + zi * fre;
        bf16* pt0 = F_PT + ((size_t)lg * 128 + 2 * pp) * 1024 + s * 16;
#pragma unroll
        for (int h = 0; h < 16; h += 2) { const float br0 = FIN(I_S5BRE)[((size_t)lg * 64 + pp) * 16 + h], bi0 = FIN(I_S5BIM)[((size_t)lg * 64 + pp) * 16 + h];
            const float br1 = FIN(I_S5BRE)[((size_t)lg * 64 + pp) * 16 + h + 1], bi1 = FIN(I_S5BIM)[((size_t)lg * 64 + pp) * 16 + h + 1];
            *(unsigned*)(pt0 + h) = pk2(zfr * br0 - zfi * bi0, zfr * br1 - zfi * bi1);
            *(unsigned*)(pt0 + 1024 + h) = pk2(zfr * bi0 + zfi * br0, zfr * bi1 + zfi * br1); }
        const float e2 = (float)(s + 1), m2 = expf(e2 * are * step), yr = m2 * cosf(e2 * aim * step), yi = m2 * sinf(e2 * aim * step);
#pragma unroll
        for (int h = 0; h < 16; ++h) { const float cr = FIN(I_S5CRE)[((size_t)lg * 16 + h) * 64 + pp], ci = FIN(I_S5CIM)[((size_t)lg * 16 + h) * 64 + pp];
            *(unsigned*)(F_QT + ((size_t)lg * 1024 + s * 16 + h) * 128 + 2 * pp) = pk2(cr * yr - ci * yi, -(cr * yi + ci * yr)); }
    }
    for (int it = gw; it < DEPTH * 16 * 64; it += NGW) {
        const int d = it & 63, lg = it >> 6, pp = F.lane;
        { const float are = FIN(I_S5ARE)[lg * 64 + pp], aim = FIN(I_S5AIM)[lg * 64 + pp], step = expf(FIN(I_S5LS)[lg]);
          const float mag = expf(are * step), lr = mag * cosf(aim * step), li = mag * sinf(aim * step);
          const float den = are * are + aim * aim, nr = lr - 1.0f, fre = (nr * are + li * aim) / den, fim = (li * are - nr * aim) / den;
          const float e1 = (float)d, m1 = expf(e1 * are * step), zr = m1 * cosf(e1 * aim * step), zi = m1 * sinf(e1 * aim * step);
          scr[2 * pp] = zr * fre - zi * fim; scr[2 * pp + 1] = zr * fim + zi * fre; }
        LDS_WAIT(); asm volatile("" ::: "memory");
        const int h = F.lane >> 2, k0 = (F.lane & 3) * 4;
        float o[4] = {0.f, 0.f, 0.f, 0.f};
        for (int p2 = 0; p2 < 64; ++p2) {
            const float zr = scr[2 * p2], zi = scr[2 * p2 + 1];
            const float cr = FIN(I_S5CRE)[((size_t)lg * 16 + h) * 64 + p2], ci = FIN(I_S5CIM)[((size_t)lg * 16 + h) * 64 + p2];
            const f32x4 br = *(const f32x4*)(FIN(I_S5BRE) + ((size_t)lg * 64 + p2) * 16 + k0), bi = *(const f32x4*)(FIN(I_S5BIM) + ((size_t)lg * 64 + p2) * 16 + k0);
#pragma unroll
            for (int e = 0; e < 4; ++e) { const float tr = zr * br[e] - zi * bi[e], ti = zr * bi[e] + zi * br[e]; o[e] += cr * tr - ci * ti; }
        }
        *(unsigned long long*)(F_KT + ((size_t)lg * 64 + d) * 256 + h * 16 + k0) = (unsigned long long)pk2(o[0], o[1]) | ((unsigned long long)pk2(o[2], o[3]) << 32);
        LDS_WAIT(); asm volatile("" ::: "memory");
    }
    for (int i = gw * 64 + F.lane; i < DEPTH * D; i += NGW * 64) { const int l = i / D, k = i % D;
        *(f32x4*)(F_WDT + (size_t)i * 4) = *(const f32x4*)(FIN(I_WIN) + ((size_t)l * D + k) * NPROJ_SRC + 2048); }
    constexpr int I_IN = (D / 64) * (NPROJ / 32), I_O = (D / 64) * (D / 32), I_1 = (D / 64) * (FF / 32), I_2 = (FF / 64) * (D / 32), I_L = I_IN + I_O + I_1 + I_2;
    for (int it = gw; it < DEPTH * I_L; it += NGW) {
        const int l = it / I_L; int r = it % I_L;
        if (r < I_IN) { p0_transpose_item(FIN(I_WIN) + (size_t)l * D * NPROJ_SRC, D, NPROJ_SRC, NPROJ / 32, 2048, 4, F_WinT + (size_t)l * NPROJ * D, scr, r, F.lane); continue; } r -= I_IN;
        if (r < I_O) { p0_transpose_item(FIN(I_WOUT) + (size_t)l * D * D, D, D, D / 32, 1 << 30, 0, F_WoutT + (size_t)l * D * D, scr, r, F.lane); continue; } r -= I_O;
        if (r < I_1) { p0_transpose_item(FIN(I_W1) + (size_t)l * D * FF, D, FF, FF / 32, 1 << 30, 0, F_W1T + (size_t)l * FF * D, scr, r, F.lane); continue; } r -= I_1;
        p0_transpose_item(FIN(I_W2) + (size_t)l * FF * D, FF, D, D / 32, 1 << 30, 0, F_W2T + (size_t)l * D * FF, scr, r, F.lane);
    }
}

__device__ __forceinline__ void norm_phase(Frame& F, const float* src, const float* nw, int l, int sh_idx, int sc_idx, bf16* dst, bool do_dt) {
    const int gw = F.vcu * NWAVES + F.wave, NGW = F.G * NWAVES, lane = opq(F.lane);
    for (int blk = gw; blk < M / 8; blk += NGW) {
        const int m0 = blk * 8, b = m0 / SEQ;
        f32x4 nwv[4], shv[4], scv[4];
#pragma unroll
        for (int j = 0; j < 4; ++j) { const int col = 4 * lane + 256 * j; nwv[j] = *(const f32x4*)(nw + col); shv[j] = modv4(F, l, b, sh_idx, col); scv[j] = modv4(F, l, b, sc_idx, col) + 1.0f;
            asm volatile("" : "+v"(shv[j]), "+v"(scv[j]) :: "memory"); }
        for (int i = 0; i < 8; ++i) {
            const int m = m0 + i;
            const f32x4* xr = (const f32x4*)(src + (size_t)m * D) + lane;
            f32x4 v[4]; float ss = 0.f;
#pragma unroll
            for (int j = 0; j < 4; ++j) { v[j] = xr[64 * j]; ss += (v[j].x * v[j].x + v[j].y * v[j].y) + (v[j].z * v[j].z + v[j].w * v[j].w); }
            const float r = 1.0f / sqrtf(wave_sum(ss) * (1.0f / D) + EPS);
            unsigned long long* o8 = (unsigned long long*)(dst + (size_t)m * D) + lane;
#pragma unroll
            for (int j = 0; j < 4; ++j) { v[j] = (v[j] * r) * nwv[j] * scv[j] + shv[j];
                o8[64 * j] = (unsigned long long)pk2(v[j].x, v[j].y) | ((unsigned long long)pk2(v[j].z, v[j].w) << 32); }
            if (do_dt) {
                const float* wdt = F_WDT + (size_t)l * D * 4 + 16 * lane;
                f32x4 d = {0.f, 0.f, 0.f, 0.f};
#pragma unroll
                for (int j = 0; j < 4; ++j)
#pragma unroll
                    for (int e = 0; e < 4; ++e) d += *(const f32x4*)(wdt + (256 * j + e) * 4) * v[j][e];
                d.x = wave_sum(d.x); d.y = wave_sum(d.y); d.z = wave_sum(d.z); d.w = wave_sum(d.w);
                if (lane == 0) *(f32x4*)(F_DT + (size_t)m * 4) = d;
            }
        }
    }
}

__device__ __forceinline__ void final_norm_phase(Frame& F) {
    const int gw = F.vcu * NWAVES + F.wave, NGW = F.G * NWAVES, lane = opq(F.lane); const float* nw = FIN(I_FNW);
    f32x4 nwv[4];
#pragma unroll
    for (int j = 0; j < 4; ++j) nwv[j] = *(const f32x4*)(nw + 4 * lane + 256 * j);
    for (int m = gw; m < M; m += NGW) {
        f32x4* xr = (f32x4*)(F_H + (size_t)m * D) + lane;
        f32x4 v[4]; float ss = 0.f;
#pragma unroll
        for (int j = 0; j < 4; ++j) { v[j] = xr[64 * j]; ss += (v[j].x * v[j].x + v[j].y * v[j].y) + (v[j].z * v[j].z + v[j].w * v[j].w); }
        const float r = 1.0f / sqrtf(wave_sum(ss) * (1.0f / D) + EPS);
#pragma unroll
        for (int j = 0; j < 4; ++j) xr[64 * j] = (v[j] * r) * nwv[j];
    }
}

typedef float f32x16 __attribute__((ext_vector_type(16)));
__device__ __forceinline__ void s5_send_item(Frame& F, int l, int j) {
    const int lane = opq(F.lane), c = lane & 31, hh = lane >> 5;
    const int g = j >> 5, mt = (j >> 2) & 7, nt = j & 3;
    const bf16* A = F_US5 + ((size_t)g * M + (size_t)(mt * 32 + c) * 64) * 16 + 8 * hh;
    const bf16* Bt = F_PT + ((size_t)(l * 16 + g) * 128 + nt * 32 + c) * 1024 + 8 * hh;
    f32x16 acc;
#pragma unroll
    for (int r = 0; r < 16; ++r) acc[r] = 0.f;
#pragma unroll 16
    for (int s = 0; s < 64; ++s) acc = __builtin_amdgcn_mfma_f32_32x32x16_bf16(*(const bf16x8*)(A + s * 16), *(const bf16x8*)(Bt + s * 16), acc, 0, 0, 0);
#pragma unroll
    for (int r = 0; r < 16; ++r) { const int row = mt * 32 + (r & 3) + 8 * (r >> 2) + 4 * hh; F_SEND[((size_t)g * NCHR + row) * 128 + nt * 32 + c] = acc[r]; }
}
constexpr int XB_KT = 0, XB_A = 32768, XB_AP = 2064, XB_SP = XB_A + 32 * XB_AP, XB_SC = XB_SP + 32 * 136 * 2;
static_assert(XB_SC + 8 * 64 * 8 <= LDSCTL_OFF, "XB LDS map");
__device__ __forceinline__ void s5_xb_item(Frame& F, int l, int b, int g, int mt, int th) {
    const int lane = opq(F.lane), wave = F.wave, c = lane & 31, hh = lane >> 5, lg = l * 16 + g;
    LAS bf16* sp = (LAS bf16*)(F.lds + XB_SP);
    typedef float f32x2v __attribute__((ext_vector_type(2)));
    LAS f32x2v* Tw = (LAS f32x2v*)(F.lds + XB_SC);
    const int crow0 = b * 128 + mt * 32;
    const int tid = wave * 64 + lane;
    { const v4u* ks = (const v4u*)(F_KT + (size_t)lg * 64 * 256); LAS v4u* kd = (LAS v4u*)(F.lds + XB_KT);
#pragma unroll
      for (int i = 0; i < 4; ++i) kd[tid + 512 * i] = ks[tid + 512 * i];
      const v4u* as = (const v4u*)(F_US5 + ((size_t)g * M + (size_t)crow0 * 64) * 16);
#pragma unroll
      for (int i = 0; i < 8; ++i) { const int q = tid + 512 * i, row = q >> 7, col = q & 127; *(LAS v4u*)(F.lds + XB_A + row * XB_AP + col * 16) = as[q]; } }
    float l64r, l64i;
    { const float are = FIN(I_S5ARE)[lg * 64 + lane], aim = FIN(I_S5AIM)[lg * 64 + lane], step = expf(FIN(I_S5LS)[lg]);
      const float m64 = expf(64.f * are * step); l64r = m64 * cosf(64.f * aim * step); l64i = m64 * sinf(64.f * aim * step); }
    float Lr[16], Li[16];
    { const float* se = F_SEND + ((size_t)g * NCHR + b * 128 + wave * 16) * 128 + 2 * lane;
      float er[16], ei[16];
#pragma unroll
      for (int i = 0; i < 16; ++i) { const f32x2v q = *(const f32x2v*)(se + (size_t)i * 128); er[i] = q.x; ei[i] = q.y; }
      float cr = 0.f, ci = 0.f;
#pragma unroll
      for (int i = 0; i < 16; ++i) { Lr[i] = cr; Li[i] = ci; const float nr = l64r * cr - l64i * ci + er[i], ni = l64r * ci + l64i * cr + ei[i]; cr = nr; ci = ni; }
      Tw[wave * 64 + lane] = (f32x2v){cr, ci}; }
    __syncthreads();
    if ((wave >> 1) == mt) {
        float pr = l64r, pi = l64i;
#pragma unroll
        for (int i = 0; i < 4; ++i) { const float nr = pr * pr - pi * pi, ni = 2.f * pr * pi; pr = nr; pi = ni; }
        float cr = 0.f, ci = 0.f;
        for (int w = 0; w < wave; ++w) { const f32x2v t = Tw[w * 64 + lane]; const float nr = pr * cr - pi * ci + t.x, ni = pr * ci + pi * cr + t.y; cr = nr; ci = ni; }
        float qr = 1.f, qi = 0.f;
#pragma unroll
        for (int i = 0; i < 16; ++i) { const float sr = Lr[i] + qr * cr - qi * ci, si = Li[i] + qr * ci + qi * cr;
            *(LAS unsigned*)(sp + ((wave & 1) * 16 + i) * 136 + 2 * lane) = pk2(sr, si);
            const float nr = qr * l64r - qi * l64i, ni = qr * l64i + qi * l64r; qr = nr; qi = ni; }
    }
    __syncthreads();
    const float dsk = FIN(I_S5D)[l * 256 + g * 16 + (c & 15)];
    bf16x8 af[8];
#pragma unroll
    for (int k = 0; k < 8; ++k) af[k] = *(const LAS bf16x8*)(sp + c * 136 + k * 16 + 8 * hh);
    const LAS unsigned char* Al = F.lds + XB_A + c * XB_AP + 16 * hh;
    const LAS unsigned char* Kl = F.lds + XB_KT + (c & 15) * 32 + 16 * hh;
    const bf16x8 zero = {0, 0, 0, 0, 0, 0, 0, 0};
#pragma unroll 1
    for (int i = 0; i < 2; ++i) {
        const int q = wave, tb = th ? ((i == 0) ? 15 - q : 16 + q) : ((i == 0) ? q : 31 - q);
        const int t = 2 * tb + (c >> 4), h = c & 15;
        const bf16* Bt = F_QT + ((size_t)lg * 1024 + tb * 32 + c) * 128 + 8 * hh;
        f32x16 acc;
#pragma unroll
        for (int r = 0; r < 16; ++r) acc[r] = 0.f;
#pragma unroll
        for (int k = 0; k < 8; ++k) acc = __builtin_amdgcn_mfma_f32_32x32x16_bf16(af[k], *(const bf16x8*)(Bt + k * 16), acc, 0, 0, 0);
        const int ns = 2 * tb + 2;
#pragma unroll 4
        for (int s = 0; s < ns; ++s) {
            const int d = t - s; const bf16x8 bl = *(const LAS bf16x8*)(Kl + (d < 0 ? 0 : d) * 512); const bf16x8 bq = (d >= 0) ? bl : zero;
            acc = __builtin_amdgcn_mfma_f32_32x32x16_bf16(*(const LAS bf16x8*)(Al + s * 32), bq, acc, 0, 0, 0);
        }
#pragma unroll
        for (int r = 0; r < 16; ++r) { const int row = crow0 + (r & 3) + 8 * (r >> 2) + 4 * hh; const size_t tok = (size_t)row * 64 + t;
            F_YS[tok * 256 + g * 16 + h] = acc[r] + dsk * bf2f(F_US5[((size_t)g * M + tok) * 16 + h]); }
    }
    __syncthreads();
}

constexpr int SPB = 272;
constexpr int SS_CM = 0, SS_BM = 128 * SPB, SS_XDT = 2 * 128 * SPB, SS_XDE = 3 * 128 * SPB, SS_F32 = 4 * 128 * SPB;
static_assert(SS_F32 + 3 * 2 * 128 * 4 <= LDSCTL_OFF, "SSD unit LDS map");
typedef short s16x4v __attribute__((ext_vector_type(4)));
__device__ __forceinline__ bf16x8 tr_frag(const LAS unsigned char* img, int k0, int n0, int lane) {
    const int i = lane & 15, q = lane >> 4;
    const LAS unsigned char* a = img + (k0 + 4 * (q >> 1) + (i >> 2)) * SPB + (n0 + 16 * (q & 1) + 4 * (i & 3)) * 2;
    const s16x4v lo = __builtin_bit_cast(s16x4v, __builtin_amdgcn_ds_read_tr16_b64_v4i16((LAS s16x4v*)a));
    const s16x4v hi = __builtin_bit_cast(s16x4v, __builtin_amdgcn_ds_read_tr16_b64_v4i16((LAS s16x4v*)(a + 8 * SPB)));
    return (bf16x8){lo[0], lo[1], lo[2], lo[3], hi[0], hi[1], hi[2], hi[3]};
}
__device__ __forceinline__ void ssd_chunk_unit(Frame& F, int l, int b, int cc, int g) {
    const int lane = opq(F.lane), wave = F.wave, c = lane & 31, hh = lane >> 5, tid = wave * 64 + lane;
    const int m0 = b * SEQ + cc * 128;
    const LAS unsigned char* Cm = F.lds + SS_CM; const LAS unsigned char* Bm = F.lds + SS_BM; const LAS unsigned char* Xdt = F.lds + SS_XDT; const LAS unsigned char* Xde = F.lds + SS_XDE;
    LAS float* dts = (LAS float*)(F.lds + SS_F32); LAS float* acs = dts + 256; LAS float* dte = dts + 512;
    if (wave < 2) {
        const int h = 2 * g + wave;
        const float dtb = FIN(I_DTB)[l * 4 + h], a = -__expf(FIN(I_ALOG)[l * 4 + h]);
        const float d0 = softplusf(F_DT[(size_t)(m0 + lane) * 4 + h] + dtb), d1 = softplusf(F_DT[(size_t)(m0 + 64 + lane) * 4 + h] + dtb);
        float v0 = a * d0, v1 = a * d1;
#pragma unroll
        for (int o = 1; o < 64; o <<= 1) { const float t0 = __shfl_up(v0, o), t1 = __shfl_up(v1, o); if (lane >= o) { v0 += t0; v1 += t1; } }
        v1 += __shfl(v0, 63);
        const float aend = __shfl(v1, 63);
        dts[wave * 128 + lane] = d0; dts[wave * 128 + 64 + lane] = d1; acs[wave * 128 + lane] = v0; acs[wave * 128 + 64 + lane] = v1;
        dte[wave * 128 + lane] = __expf(aend - v0); dte[wave * 128 + 64 + lane] = __expf(aend - v1);
        F_ACS[(size_t)(m0 + lane) * 4 + h] = v0; F_ACS[(size_t)(m0 + 64 + lane) * 4 + h] = v1;
    }
    __syncthreads();
    if (tid < 480) {
        const int o = tid % 48, tg = tid / 48, t0 = tg * 13, nt = (t0 + 13 <= 128) ? 13 : (128 - t0);
        const int cho = (o < 16) ? (g * 128 + o * 8) : (o < 32) ? (256 + g * 128 + (o - 16) * 8) : (512 + g * 128 + (o - 32) * 8);
        const float* cw = FIN(I_SSDCW) + (size_t)l * 4 * 768 + cho; const float* cbias = FIN(I_SSDCB) + (size_t)l * 768 + cho;
        float w[4][8], bs[8];
#pragma unroll
        for (int k = 0; k < 4; ++k) { const f32x4 a0 = *(const f32x4*)(cw + k * 768), a1 = *(const f32x4*)(cw + k * 768 + 4);
#pragma unroll
            for (int e = 0; e < 4; ++e) { w[k][e] = a0[e]; w[k][4 + e] = a1[e]; } }
        { const f32x4 a0 = *(const f32x4*)cbias, a1 = *(const f32x4*)(cbias + 4);
#pragma unroll
          for (int e = 0; e < 4; ++e) { bs[e] = a0[e]; bs[4 + e] = a1[e]; } }
        const bf16* src = F_PROJ + (size_t)(m0 + t0) * NPP + PC_X + cho;
        const int tseq = cc * 128 + t0;
        v4u raw[16];
#pragma unroll
        for (int i = 0; i < 16; ++i) { const bool ok = (tseq + i - 3 >= 0) && (i - 3 < nt); raw[i] = ok ? *(const v4u*)(src + (long)(i - 3) * NPP) : (v4u){0u, 0u, 0u, 0u}; }
        const int hd = o >> 3;
        LAS unsigned char* img = F.lds + ((o < 16) ? SS_XDT : (o < 32) ? SS_BM : SS_CM) + ((o & 15) * 8) * 2;
#pragma unroll
        for (int i = 0; i < 13; ++i) {
            if (i < nt) {
                const int tl = t0 + i; float v[8];
#pragma unroll
                for (int e = 0; e < 8; ++e) {
                    float acc = bs[e];
#pragma unroll
                    for (int k = 0; k < 4; ++k) { const unsigned wd = raw[i + k][e >> 1]; const float x = (e & 1) ? __uint_as_float(wd & 0xffff0000u) : __uint_as_float(wd << 16); acc += w[k][e] * x; }
                    v[e] = siluf(acc);
                }
                if (o < 16) {
                    *(v4u*)(F_XS + (size_t)(m0 + tl) * 256 + g * 128 + o * 8) = (v4u){pk2(v[0], v[1]), pk2(v[2], v[3]), pk2(v[4], v[5]), pk2(v[6], v[7])};
                    const float sd = dts[hd * 128 + tl], se = sd * dte[hd * 128 + tl];
                    *(LAS v4u*)(img + tl * SPB) = (v4u){pk2(v[0] * sd, v[1] * sd), pk2(v[2] * sd, v[3] * sd), pk2(v[4] * sd, v[5] * sd), pk2(v[6] * sd, v[7] * sd)};
                    *(LAS v4u*)(img + (SS_XDE - SS_XDT) + tl * SPB) = (v4u){pk2(v[0] * se, v[1] * se), pk2(v[2] * se, v[3] * se), pk2(v[4] * se, v[5] * se), pk2(v[6] * se, v[7] * se)};
                } else {
                    const v4u q = (v4u){pk2(v[0], v[1]), pk2(v[2], v[3]), pk2(v[4], v[5]), pk2(v[6], v[7])};
                    *(LAS v4u*)(img + tl * SPB) = q;
                    if (o >= 32) *(v4u*)(F_CS + (size_t)(m0 + tl) * 256 + g * 128 + (o - 32) * 8) = q;
                }
            }
        }
    }
    __syncthreads();
    {
        const int j = wave & 3, pt = wave >> 2;
        bf16x8 cf[8];
#pragma unroll
        for (int ks = 0; ks < 8; ++ks) cf[ks] = *(const LAS bf16x8*)(Cm + (j * 32 + c) * SPB + (ks * 16 + 8 * hh) * 2);
        const float al0 = acs[j * 32 + c], al1 = acs[128 + j * 32 + c];
        f32x16 y0, y1;
#pragma unroll
        for (int r = 0; r < 16; ++r) { y0[r] = 0.f; y1[r] = 0.f; }
        for (int i = 0; i <= j; ++i) {
            f32x16 X;
#pragma unroll
            for (int r = 0; r < 16; ++r) X[r] = 0.f;
#pragma unroll
            for (int ks = 0; ks < 8; ++ks) X = __builtin_amdgcn_mfma_f32_32x32x16_bf16(*(const LAS bf16x8*)(Bm + (i * 32 + c) * SPB + (ks * 16 + 8 * hh) * 2), cf[ks], X, 0, 0, 0);
            f32x16 X0, X1;
#pragma unroll
            for (int r = 0; r < 16; ++r) { const int s = i * 32 + (r & 3) + 8 * (r >> 2) + 4 * hh; const bool ok = (s <= j * 32 + c);
                X0[r] = ok ? X[r] * __expf(al0 - acs[s]) : 0.f; X1[r] = ok ? X[r] * __expf(al1 - acs[128 + s]) : 0.f; }
#pragma unroll
            for (int ks2 = 0; ks2 < 2; ++ks2) {
                bf16x8 xa0, xa1; unsigned* w0 = (unsigned*)&xa0; unsigned* w1 = (unsigned*)&xa1;
#pragma unroll
                for (int e = 0; e < 4; ++e) { w0[e] = pk2(X0[8 * ks2 + 2 * e], X0[8 * ks2 + 2 * e + 1]); w1[e] = pk2(X1[8 * ks2 + 2 * e], X1[8 * ks2 + 2 * e + 1]); }
                y0 = __builtin_amdgcn_mfma_f32_32x32x16_bf16(xa0, tr_frag(Xdt, i * 32 + 16 * ks2, pt * 32, lane), y0, 0, 0, 0);
                y1 = __builtin_amdgcn_mfma_f32_32x32x16_bf16(xa1, tr_frag(Xdt, i * 32 + 16 * ks2, 64 + pt * 32, lane), y1, 0, 0, 0);
            }
        }
#pragma unroll
        for (int r = 0; r < 16; ++r) { const int tl = j * 32 + (r & 3) + 8 * (r >> 2) + 4 * hh; float* yo = F_YC + (size_t)(m0 + tl) * 256 + g * 128 + pt * 32 + c; yo[0] = y0[r]; yo[64] = y1[r]; }
#pragma unroll
        for (int hd = 0; hd < 2; ++hd) {
            f32x16 st;
#pragma unroll
            for (int r = 0; r < 16; ++r) st[r] = 0.f;
#pragma unroll
            for (int ks = 0; ks < 8; ++ks) st = __builtin_amdgcn_mfma_f32_32x32x16_bf16(tr_frag(Xde, 16 * ks, hd * 64 + pt * 32, lane), tr_frag(Bm, 16 * ks, j * 32, lane), st, 0, 0, 0);
            float* so = F_ST + ((size_t)((b * 64 + cc) * 4 + 2 * g + hd) * 64) * 128;
#pragma unroll
            for (int r = 0; r < 16; ++r) { const int pp = pt * 32 + (r & 3) + 8 * (r >> 2) + 4 * hh; so[(size_t)pp * 128 + j * 32 + c] = st[r]; }
        }
    }
    __syncthreads();
}
__device__ __forceinline__ void ssd_scan_item(Frame& F, int gws) {
    const int e = gws * 64 + opq(F.lane), bh = e >> 13, pn = e & 8191, b = bh >> 2, h = bh & 3;
    const float* st = F_ST + ((size_t)(b * 64 * 4 + h) * 8192) + pn; bf16* pv = F_PREV + ((size_t)(b * 64 * 4 + h) * 8192) + pn;
    const float* ae = F_ACS + ((size_t)b * SEQ + 127) * 4 + h;
    float carry = 0.f;
    for (int c0 = 0; c0 < 64; c0 += 16) {
        float sv[16], dv[16];
#pragma unroll
        for (int i = 0; i < 16; ++i) { sv[i] = st[(size_t)(c0 + i) * 4 * 8192]; dv[i] = ae[(size_t)(c0 + i) * 128 * 4]; }
#pragma unroll
        for (int i = 0; i < 16; ++i) { pv[(size_t)(c0 + i) * 4 * 8192] = (bf16)f2bf(carry); carry = carry * __expf(dv[i]) + sv[i]; }
    }
}
constexpr int YP = 2064;
static_assert(64 * YP <= LDSCTL_OFF, "XC LDS map");
__device__ __forceinline__ float bflo(unsigned w) { return __uint_as_float(w << 16); }
__device__ __forceinline__ float bfhi(unsigned w) { return __uint_as_float(w & 0xffff0000u); }
__device__ __forceinline__ void xc_tile(Frame& F, int l, int tile) {
    const int lane = opq(F.lane), wave = F.wave, c = lane & 31, hh = lane >> 5, tid = wave * 64 + lane;
    const int m0 = tile * 64, b = m0 / SEQ, tseq0 = m0 & (SEQ - 1), cc = tseq0 >> 7;
    LAS unsigned char* Y = F.lds;
    {
        const int h = wave >> 1, lbl = wave & 1, g = h >> 1, mr = m0 + lbl * 32;
        const bf16* A = F_CS + (size_t)(mr + c) * 256 + g * 128 + 8 * hh;
        const bf16* Bt = F_PREV + ((size_t)((b * 64 + cc) * 4 + h) * 8192) + (size_t)c * 128 + 8 * hh;
        f32x16 a0, a1;
#pragma unroll
        for (int r = 0; r < 16; ++r) { a0[r] = 0.f; a1[r] = 0.f; }
#pragma unroll
        for (int ks = 0; ks < 8; ++ks) { const bf16x8 af = *(const bf16x8*)(A + ks * 16);
            a0 = __builtin_amdgcn_mfma_f32_32x32x16_bf16(af, *(const bf16x8*)(Bt + ks * 16), a0, 0, 0, 0);
            a1 = __builtin_amdgcn_mfma_f32_32x32x16_bf16(af, *(const bf16x8*)(Bt + 32 * 128 + ks * 16), a1, 0, 0, 0); }
        const float Dk = FIN(I_SSDD)[l * 4 + h];
#pragma unroll
        for (int r = 0; r < 16; ++r) { const int rl = lbl * 32 + (r & 3) + 8 * (r >> 2) + 4 * hh; const size_t m = (size_t)(m0 + rl); const float ea = __expf(F_ACS[m * 4 + h]);
#pragma unroll
            for (int pt = 0; pt < 2; ++pt) { const int ch = h * 64 + pt * 32 + c; const float acc = pt ? a1[r] : a0[r];
                const float y = (F_YC[m * 256 + ch] + acc * ea + Dk * bf2f(F_XS[m * 256 + ch])) * siluf(bf2f(F_PROJ[m * NPP + PC_Z + ch]));
                *(LAS bf16*)(Y + rl * YP + (512 + ch) * 2) = (bf16)f2bf(y); } }
    }
    const int oct = tid & 31, rg = tid >> 5;
    {
        const int win = 2 << (oct >> 3);
        const bf16* src = F_PROJ + (size_t)(m0 + rg * 4) * NPP + PC_POOL + oct * 8;
        v4u raw[19];
#pragma unroll
        for (int r = 0; r < 19; ++r) { const bool ok = (r >= 16 - win) && (tseq0 + rg * 4 + r - 15 >= 0); raw[r] = ok ? *(const v4u*)(src + (long)(r - 15) * NPP) : (v4u){0u, 0u, 0u, 0u}; }
        float s[4][8];
#pragma unroll
        for (int i = 0; i < 4; ++i)
#pragma unroll
            for (int e = 0; e < 8; ++e) s[i][e] = 0.f;
#pragma unroll
        for (int r = 0; r < 19; ++r) {
            float x[8];
#pragma unroll
            for (int e = 0; e < 4; ++e) { x[2 * e] = bflo(raw[r][e]); x[2 * e + 1] = bfhi(raw[r][e]); }
#pragma unroll
            for (int i = 0; i < 4; ++i) { const int j = 15 + i - r;
                if (j >= 0 && j < 16) { const bool in = j < win;
#pragma unroll
                    for (int e = 0; e < 8; ++e) s[i][e] += in ? x[e] : 0.f; } }
        }
#pragma unroll
        for (int i = 0; i < 4; ++i) { const int t = tseq0 + rg * 4 + i; const int cnt = (t + 1 < win) ? (t + 1) : win; const float ic = 1.0f / (float)cnt;
            float pv[8];
#pragma unroll
            for (int e = 0; e < 4; ++e) { pv[2 * e] = s[i][2 * e] * ic - bflo(raw[15 + i][e]); pv[2 * e + 1] = s[i][2 * e + 1] * ic - bfhi(raw[15 + i][e]); }
            *(LAS v4u*)(Y + (rg * 4 + i) * YP + (oct * 8) * 2) = (v4u){pk2(pv[0], pv[1]), pk2(pv[2], pv[3]), pk2(pv[4], pv[5]), pk2(pv[6], pv[7])}; }
    }
    {
        const bf16* row0 = F_PROJ + (size_t)(m0 + rg * 4) * NPP + oct * 8;
        const float* sw = FIN(I_SCONVW) + (size_t)l * 3 * 256 + oct * 8;
        v4u gb[4], gc[6], hv[6];
#pragma unroll
        for (int i = 0; i < 4; ++i) gb[i] = *(const v4u*)(row0 + (long)i * NPP + PC_GB);
#pragma unroll
        for (int r = 0; r < 6; ++r) { const bool ok = (tseq0 + rg * 4 + r - 2 >= 0);
            gc[r] = ok ? *(const v4u*)(row0 + (long)(r - 2) * NPP + PC_GC) : (v4u){0u, 0u, 0u, 0u}; hv[r] = ok ? *(const v4u*)(row0 + (long)(r - 2) * NPP + PC_H) : (v4u){0u, 0u, 0u, 0u}; }
        float w[3][8];
#pragma unroll
        for (int k = 0; k < 3; ++k) { const f32x4 a0 = *(const f32x4*)(sw + k * 256), a1 = *(const f32x4*)(sw + k * 256 + 4);
#pragma unroll
            for (int e = 0; e < 4; ++e) { w[k][e] = a0[e]; w[k][4 + e] = a1[e]; } }
        float pr[6][8];
#pragma unroll
        for (int r = 0; r < 6; ++r)
#pragma unroll
            for (int e = 0; e < 4; ++e) { pr[r][2 * e] = bflo(gc[r][e]) * bflo(hv[r][e]); pr[r][2 * e + 1] = bfhi(gc[r][e]) * bfhi(hv[r][e]); }
#pragma unroll
        for (int i = 0; i < 4; ++i) { float yv[8];
#pragma unroll
            for (int e = 0; e < 8; ++e) { const float a = w[0][e] * pr[i][e] + w[1][e] * pr[i + 1][e] + w[2][e] * pr[i + 2][e]; const unsigned gw_ = gb[i][e >> 1]; yv[e] = ((e & 1) ? bfhi(gw_) : bflo(gw_)) * a; }
            *(LAS v4u*)(Y + (rg * 4 + i) * YP + (256 + oct * 8) * 2) = (v4u){pk2(yv[0], yv[1]), pk2(yv[2], yv[3]), pk2(yv[4], yv[5]), pk2(yv[6], yv[7])}; }
    }
    {
        const int row = tid >> 3, part = tid & 7;
        const float* ys = F_YS + (size_t)(m0 + row) * 256 + part * 32;
#pragma unroll
        for (int q = 0; q < 4; ++q) { const f32x4 a0 = *(const f32x4*)(ys + q * 8), a1 = *(const f32x4*)(ys + q * 8 + 4);
            *(LAS v4u*)(Y + row * YP + (768 + part * 32 + q * 8) * 2) = (v4u){pk2(gelu_tanh(a0[0]), gelu_tanh(a0[1])), pk2(gelu_tanh(a0[2]), gelu_tanh(a0[3])), pk2(gelu_tanh(a1[0]), gelu_tanh(a1[1])), pk2(gelu_tanh(a1[2]), gelu_tanh(a1[3]))}; }
    }
    __syncthreads();
    float ya[2][16], yd[2][16];
    {
        const int mt = wave & 1, wq = wave >> 1;
        { const bf16* Bt = F_PWT + ((size_t)(l * 4 + wq) * 64 + c) * 64 + 8 * hh;
          f32x16 p0, p1;
#pragma unroll
          for (int r = 0; r < 16; ++r) { p0[r] = 0.f; p1[r] = 0.f; }
#pragma unroll
          for (int ks = 0; ks < 4; ++ks) { const bf16x8 af = *(const LAS bf16x8*)(Y + (mt * 32 + c) * YP + (wq * 64 + ks * 16 + 8 * hh) * 2);
              p0 = __builtin_amdgcn_mfma_f32_32x32x16_bf16(af, *(const bf16x8*)(Bt + ks * 16), p0, 0, 0, 0);
              p1 = __builtin_amdgcn_mfma_f32_32x32x16_bf16(af, *(const bf16x8*)(Bt + 32 * 64 + ks * 16), p1, 0, 0, 0); }
          const float sc0 = FIN(I_POOLS)[l * 256 + wq * 64 + c], sc1 = FIN(I_POOLS)[l * 256 + wq * 64 + 32 + c];
#pragma unroll
          for (int r = 0; r < 16; ++r) { ya[0][r] = p0[r] * sc0; ya[1][r] = p1[r] * sc1; } }
        { const bf16* Bt = F_GWT + ((size_t)l * 256 + wq * 64 + c) * 256 + 8 * hh;
          f32x16 q0, q1;
#pragma unroll
          for (int r = 0; r < 16; ++r) { q0[r] = 0.f; q1[r] = 0.f; }
#pragma unroll
          for (int ks = 0; ks < 16; ++ks) { const bf16x8 af = *(const LAS bf16x8*)(Y + (mt * 32 + c) * YP + (768 + ks * 16 + 8 * hh) * 2);
              q0 = __builtin_amdgcn_mfma_f32_32x32x16_bf16(af, *(const bf16x8*)(Bt + ks * 16), q0, 0, 0, 0);
              q1 = __builtin_amdgcn_mfma_f32_32x32x16_bf16(af, *(const bf16x8*)(Bt + 32 * 256 + ks * 16), q1, 0, 0, 0); }
          const float gb0 = FIN(I_GLUB)[l * 256 + wq * 64 + c], gb1 = FIN(I_GLUB)[l * 256 + wq * 64 + 32 + c];
#pragma unroll
          for (int r = 0; r < 16; ++r) { const int rl = mt * 32 + (r & 3) + 8 * (r >> 2) + 4 * hh;
              const float g0 = bf2f(*(const LAS bf16*)(Y + rl * YP + (768 + wq * 64 + c) * 2)), g1 = bf2f(*(const LAS bf16*)(Y + rl * YP + (768 + wq * 64 + 32 + c) * 2));
              yd[0][r] = g0 * sigmf(q0[r] + gb0); yd[1][r] = g1 * sigmf(q1[r] + gb1); } }
    }
    __syncthreads();
    {
        const int mt = wave & 1, wq = wave >> 1;
#pragma unroll
        for (int r = 0; r < 16; ++r) { const int rl = mt * 32 + (r & 3) + 8 * (r >> 2) + 4 * hh; LAS unsigned char* rowp = Y + rl * YP;
            *(LAS bf16*)(rowp + (wq * 64 + c) * 2) = (bf16)f2bf(ya[0][r]); *(LAS bf16*)(rowp + (wq * 64 + 32 + c) * 2) = (bf16)f2bf(ya[1][r]);
            *(LAS bf16*)(rowp + (768 + wq * 64 + c) * 2) = (bf16)f2bf(yd[0][r]); *(LAS bf16*)(rowp + (768 + wq * 64 + 32 + c) * 2) = (bf16)f2bf(yd[1][r]); }
    }
    __syncthreads();
    {
        const float* bnw = FIN(I_BNW) + (size_t)l * D;
        float wv[16];
#pragma unroll
        for (int q = 0; q < 2; ++q) { const f32x4 a0 = *(const f32x4*)(bnw + q * 512 + lane * 8), a1 = *(const f32x4*)(bnw + q * 512 + lane * 8 + 4);
#pragma unroll
            for (int e = 0; e < 4; ++e) { wv[q * 8 + e] = a0[e]; wv[q * 8 + 4 + e] = a1[e]; } }
#pragma unroll 2
        for (int i = 0; i < 8; ++i) { const int rl = wave * 8 + i;
            const v4u u0 = *(const LAS v4u*)(Y + rl * YP + lane * 16), u1 = *(const LAS v4u*)(Y + rl * YP + 1024 + lane * 16);
            float x[16]; float s0 = 0.f, s1 = 0.f;
#pragma unroll
            for (int e = 0; e < 4; ++e) { x[2 * e] = bflo(u0[e]); x[2 * e + 1] = bfhi(u0[e]); x[8 + 2 * e] = bflo(u1[e]); x[8 + 2 * e + 1] = bfhi(u1[e]); }
#pragma unroll
            for (int e = 0; e < 8; ++e) { s0 += x[e] * x[e]; s1 += x[8 + e] * x[8 + e]; }
#pragma unroll
            for (int o = 1; o < 32; o <<= 1) { s0 += __shfl_xor(s0, o); s1 += __shfl_xor(s1, o); }
            const float r0 = 1.0f / sqrtf(s0 * (1.0f / 256.f) + EPS), r1 = 1.0f / sqrtf(s1 * (1.0f / 256.f) + EPS);
            bf16* go = F_GROUPS + (size_t)(m0 + rl) * D + lane * 8;
            *(v4u*)go = (v4u){pk2(x[0] * r0 * wv[0], x[1] * r0 * wv[1]), pk2(x[2] * r0 * wv[2], x[3] * r0 * wv[3]), pk2(x[4] * r0 * wv[4], x[5] * r0 * wv[5]), pk2(x[6] * r0 * wv[6], x[7] * r0 * wv[7])};
            *(v4u*)(go + 512) = (v4u){pk2(x[8] * r1 * wv[8], x[9] * r1 * wv[9]), pk2(x[10] * r1 * wv[10], x[11] * r1 * wv[11]), pk2(x[12] * r1 * wv[12], x[13] * r1 * wv[13]), pk2(x[14] * r1 * wv[14], x[15] * r1 * wv[15])}; }
    }
    __syncthreads();
}

#ifndef PROBE_DBL
#define PROBE_DBL 0
#endif
template <int l> __device__ __forceinline__ void layer_body(Frame& F, const XcdBarrier& bar) {
#define GRID_BAR() do { xcd_barrier(bar); if (PROBE_DBL == 11) xcd_barrier(bar); } while (0)
        const float* hsrc = (l == 0) ? FIN(I_X) : F_H;
    norm_phase(F, hsrc, FIN(I_NMIX) + l * D, l, 0, 1, F_UV, true);
    if (PROBE_DBL == 1) norm_phase(F, hsrc, FIN(I_NMIX) + l * D, l, 0, 1, F_UV, true);
    GRID_BAR();
    { pg8::Gemm g{F_UV, F_WinT + (size_t)l * NPROJ * D, M, 2048, D}; pg8::StaticOrder S; S.init(M, 2048, F.G, (int)blockIdx.x);
      pg8::EpiBf16<0> E{F_PROJ, NPP};
      pg8::gemm_phase<pg8::EpiBf16<0>, pg8::StaticOrder, true, true>(F.lds + RING_OFF, g, S, E); }
    { pg8::Gemm g{F_UV, F_WinT + (size_t)l * NPROJ * D + (size_t)2048 * D, M, 256, D}; pg8::StaticOrder S; S.init(M, 256, F.G, (int)blockIdx.x);
      pg8::EpiCompact16 E{F_US5, M};
      pg8::gemm_phase<pg8::EpiCompact16, pg8::StaticOrder, true, true>(F.lds + RING_OFF, g, S, E); }
    if (PROBE_DBL == 2) {
    { pg8::Gemm g{F_UV, F_WinT + (size_t)l * NPROJ * D, M, 2048, D}; pg8::StaticOrder S; S.init(M, 2048, F.G, (int)blockIdx.x);
      pg8::EpiBf16<0> E{F_PROJ, NPP};
      pg8::gemm_phase<pg8::EpiBf16<0>, pg8::StaticOrder, true, true>(F.lds + RING_OFF, g, S, E); }
    { pg8::Gemm g{F_UV, F_WinT + (size_t)l * NPROJ * D + (size_t)2048 * D, M, 256, D}; pg8::StaticOrder S; S.init(M, 256, F.G, (int)blockIdx.x);
      pg8::EpiCompact16 E{F_US5, M};
      pg8::gemm_phase<pg8::EpiCompact16, pg8::StaticOrder, true, true>(F.lds + RING_OFF, g, S, E); }
    }
    GRID_BAR();
    for (int u = F.vcu; u < 256; u += F.G) ssd_chunk_unit(F, l, u >> 7, (u >> 1) & 63, u & 1);
    if ((F.wave & 3) == 0) { for (int it = F.vcu * 2 + (F.wave >> 2); it < 512; it += F.G * 2) s5_send_item(F, l, it); }
    if (PROBE_DBL == 12) { for (int u = F.vcu; u < 256; u += F.G) ssd_chunk_unit(F, l, u >> 7, (u >> 1) & 63, u & 1); }
    if (PROBE_DBL == 13) { if ((F.wave & 3) == 0) { for (int it = F.vcu * 2 + (F.wave >> 2); it < 512; it += F.G * 2) s5_send_item(F, l, it); } }
    GRID_BAR();
    s5_xb_item(F, l, F.vcu >> 7, (F.vcu >> 3) & 15, (F.vcu >> 1) & 3, F.vcu & 1);
    if (F.wave < 4) ssd_scan_item(F, F.vcu * 4 + F.wave);
    if (PROBE_DBL == 4 || PROBE_DBL == 15) s5_xb_item(F, l, F.vcu >> 7, (F.vcu >> 3) & 15, (F.vcu >> 1) & 3, F.vcu & 1);
    if (PROBE_DBL == 4 || PROBE_DBL == 16) { if (F.wave < 4) ssd_scan_item(F, F.vcu * 4 + F.wave); }
    GRID_BAR();
    for (int t = F.vcu; t < M / 64; t += F.G) xc_tile(F, l, t);
    if (PROBE_DBL == 6) { for (int t = F.vcu; t < M / 64; t += F.G) xc_tile(F, l, t); }
    GRID_BAR();
    { pg8::Gemm g{F_GROUPS, F_WoutT + (size_t)l * D * D, M, D, D}; pg8::StaticOrder S; S.init(M, D, F.G, (int)blockIdx.x);
      pg8::EpiResGate E{hsrc, F_H, D, F_MODP + (size_t)l * 2 * MOD + 2 * D, FIN(I_ADAB) + (size_t)l * MOD + 2 * D, 2 * 2 * MOD, MOD, SEQ};
      pg8::gemm_phase<pg8::EpiResGate, pg8::StaticOrder, true, true>(F.lds + RING_OFF, g, S, E); }
    GRID_BAR();
    norm_phase(F, F_H, FIN(I_NMLP) + l * D, l, 3, 4, F_UV, false);
    if (PROBE_DBL == 7) norm_phase(F, F_H, FIN(I_NMLP) + l * D, l, 3, 4, F_UV, false);
    GRID_BAR();
    { pg8::Gemm g{F_UV, F_W1T + (size_t)l * FF * D, M, FF, D}; pg8::StaticOrder S; S.init(M, FF, F.G, (int)blockIdx.x);
      pg8::EpiBf16<2> E{F_HID, FF};
      pg8::gemm_phase<pg8::EpiBf16<2>, pg8::StaticOrder, true, true>(F.lds + RING_OFF, g, S, E); }
    if (PROBE_DBL == 8)
    { pg8::Gemm g{F_UV, F_W1T + (size_t)l * FF * D, M, FF, D}; pg8::StaticOrder S; S.init(M, FF, F.G, (int)blockIdx.x);
      pg8::EpiBf16<2> E{F_HID, FF};
      pg8::gemm_phase<pg8::EpiBf16<2>, pg8::StaticOrder, true, true>(F.lds + RING_OFF, g, S, E); }
    GRID_BAR();
    { pg8::Gemm g{F_HID, F_W2T + (size_t)l * D * FF, M, D, FF}; pg8::StaticOrder S; S.init(M, D, F.G, (int)blockIdx.x);
      pg8::EpiResGate E{F_H, F_H, D, F_MODP + (size_t)l * 2 * MOD + 5 * D, FIN(I_ADAB) + (size_t)l * MOD + 5 * D, 2 * 2 * MOD, MOD, SEQ};
      pg8::gemm_phase<pg8::EpiResGate, pg8::StaticOrder, true, true>(F.lds + RING_OFF, g, S, E); }
    GRID_BAR();
}

struct Args { const float* in[N_IN]; float* out; unsigned char* ws; };
__global__ void __launch_bounds__(NWAVES * 64, 2) mk_fwd(Args args_unused) {
    extern __shared__ __attribute__((aligned(16))) unsigned char lds[];
    Frame F;
    F.lds = (LAS unsigned char*)lds;
    F.MISC = (volatile LAS unsigned*)(F.lds + MISC_OFF);
    F.tid = threadIdx.x; F.lane = F.tid & 63; F.wave = __builtin_amdgcn_readfirstlane(F.tid >> 6);
    F.G = gridDim.x; { const int bx = blockIdx.x; F.vcu = (F.G % 8 == 0) ? (bx % 8) * (F.G / 8) + bx / 8 : bx; }
    F.karg = (const __attribute__((address_space(4))) unsigned char*)__builtin_amdgcn_kernarg_segment_ptr();
    F.ws = *(unsigned char* const __attribute__((address_space(4)))*)(F.karg + 8 * (N_IN + 1));
    F.ctl = (gu32*)(F.ws + WS_CTL);
    for (int u = F.tid; u < (LDS_BYTES - LDSCTL_OFF) / 4; u += NWAVES * 64) ((LAS unsigned*)(F.lds + LDSCTL_OFF))[u] = 0u;
    __syncthreads();
    XcdBarrier bar = xcd_barrier_post((unsigned*)(F.ctl + CW_BAR), F.MISC + 8);

    p0_prologue(F);
    if (PROBE_DBL == 9) p0_prologue(F);
    GRID_BAR();
    layer_body<0>(F, bar);
    layer_body<1>(F, bar);
    final_norm_phase(F);
}

extern "C" void kernel_launch(void* const* d_in, const int* in_sizes, int n_in, void* d_out, int out_size, void* d_ws, size_t ws_size, hipStream_t stream) {
    static int grid = 0;
    if (grid == 0) {
        if (n_in != N_IN || in_sizes[0] != M * D || out_size != M * D || ws_size < WS_END) { fprintf(stderr, "kernel_launch: unexpected shapes (n_in %d, in0 %d, out %d, ws %zu); nothing launched\n", n_in, n_in > 0 ? in_sizes[0] : -1, out_size, ws_size); grid = -1; return; }
        int dev = 0, cus = 0, per_cu = 0;
        if (hipGetDevice(&dev) != hipSuccess || hipDeviceGetAttribute(&cus, hipDeviceAttributeMultiprocessorCount, dev) != hipSuccess) { grid = -1; return; }
        if (hipFuncSetAttribute((const void*)mk_fwd, hipFuncAttributeMaxDynamicSharedMemorySize, LDS_BYTES) != hipSuccess) { fprintf(stderr, "kernel_launch: hipFuncSetAttribute failed\n"); grid = -1; return; }
        if (hipOccupancyMaxActiveBlocksPerMultiprocessor(&per_cu, (const void*)mk_fwd, NWAVES * 64, LDS_BYTES) != hipSuccess || per_cu < 1) fprintf(stderr, "kernel_launch: occupancy query reports %d\n", per_cu);
        (void)hipGetLastError();
        grid = cus;
    }
    if (grid < 0) return;
    if (hipMemsetAsync((char*)d_ws + WS_CTL, 0, CTL_ZERO_BYTES, stream) != hipSuccess) return;
    Args a{};
    for (int i = 0; i < N_IN; ++i) a.in[i] = (const float*)d_in[i];
    a.out = (float*)d_out; a.ws = (unsigned char*)d_ws;
    hipLaunchKernelGGL(mk_fwd, dim3(grid), dim3(NWAVES * 64), LDS_BYTES, stream, a);
}
```
